# Optimizing an MI355X kernel written in HIP

```python
import jax, jax.numpy as jnp
from jax import lax
import numpy as np

D_MODEL = 1024
BATCH = 8
SEQ = 2048
DEPTH = 4

ATTN_WIDTH = D_MODEL // 2
RET_WIDTH = D_MODEL - ATTN_WIDTH
HEAD_DIM = 64
N_ATTN_HEADS = ATTN_WIDTH // HEAD_DIM
N_KV_HEADS = 2
GQA_GROUP = N_ATTN_HEADS // N_KV_HEADS
KV_WIDTH = N_KV_HEADS * HEAD_DIM
WINDOW = 128
ATTN_BLOCK = 128
N_RET_HEADS = 4
RET_HEAD_DIM = RET_WIDTH // N_RET_HEADS
RET_CHUNK = 128
ROPE_BASE = 10000.0
D_FF = 2816
NORM_EPS = 1e-6
GN_EPS = 1e-5
NEG_INF = -1e30
IN_WIDTHS = (ATTN_WIDTH, KV_WIDTH, KV_WIDTH, RET_WIDTH, RET_WIDTH, RET_WIDTH, RET_WIDTH)
IN_SPLITS = tuple(int(v) for v in np.cumsum(IN_WIDTHS)[:-1])
D_IN = int(sum(IN_WIDTHS))

kernel_name = "hymba_style_swa_sink_retention_macaron"


def rms_norm(x, w):
    xf = x.astype(jnp.float32)
    y = xf * lax.rsqrt(jnp.mean(xf * xf, axis=-1, keepdims=True) + NORM_EPS)
    return (y * w.astype(jnp.float32)).astype(x.dtype)


def swiglu(h, w_gate, w_up, w_down):
    return (jax.nn.silu(h @ w_gate) * (h @ w_up)) @ w_down


def sliding_window_sink_attention(q, k, v, sinks):
    B, S, _ = q.shape
    nb = S // ATTN_BLOCK
    q = q.reshape(B, nb, ATTN_BLOCK, N_KV_HEADS, GQA_GROUP, HEAD_DIM)
    k = k.reshape(B, nb, ATTN_BLOCK, N_KV_HEADS, HEAD_DIM)
    v = v.reshape(B, nb, ATTN_BLOCK, N_KV_HEADS, HEAD_DIM)
    pad = ((0, 0), (1, 0), (0, 0), (0, 0), (0, 0))
    kk = jnp.concatenate([jnp.pad(k[:, :-1], pad), k], axis=2)
    vv = jnp.concatenate([jnp.pad(v[:, :-1], pad), v], axis=2)
    s = jnp.einsum('bnqhgd,bnkhd->bnhgqk', q, kk).astype(jnp.float32) * (HEAD_DIM ** -0.5)
    blk = jnp.arange(nb)[:, None, None]
    qi = jnp.arange(ATTN_BLOCK)[None, :, None]
    kj = jnp.arange(2 * ATTN_BLOCK)[None, None, :]
    diff = ATTN_BLOCK + qi - kj
    kpos = (blk - 1) * ATTN_BLOCK + kj
    mask = (diff >= 0) & (diff < WINDOW) & (kpos >= 0)
    s = jnp.where(mask[None, :, None, None], s, NEG_INF)
    sink = sinks.astype(jnp.float32).reshape(1, 1, N_KV_HEADS, GQA_GROUP, 1, 1)
    m = jnp.maximum(jnp.max(s, axis=-1, keepdims=True), sink)
    p = jnp.exp(s - m)
    denom = jnp.sum(p, axis=-1, keepdims=True) + jnp.exp(sink - m)
    probs = (p / denom).astype(v.dtype)
    out = jnp.einsum('bnhgqk,bnkhd->bnqhgd', probs, vv)
    return out.reshape(B, S, ATTN_WIDTH)


def rotary(x, cos, sin):
    half = x.shape[-1] // 2
    x1, x2 = x[..., :half], x[..., half:]
    c = cos[None, :, None, :].astype(x.dtype)
    s = sin[None, :, None, :].astype(x.dtype)
    return jnp.concatenate([x1 * c - x2 * s, x1 * s + x2 * c], axis=-1)


def multiscale_retention(q, k, v, g, gn_w):
    B, S, _ = q.shape
    H, D, C = N_RET_HEADS, RET_HEAD_DIM, RET_CHUNK
    nc = S // C
    pos = jnp.arange(S, dtype=jnp.float32)
    inv_freq = ROPE_BASE ** (-jnp.arange(0, D, 2, dtype=jnp.float32) / D)
    ang = pos[:, None] * inv_freq[None, :]
    cos, sin = jnp.cos(ang), jnp.sin(ang)
    q = rotary(q.reshape(B, S, H, D), cos, sin)
    k = rotary(k.reshape(B, S, H, D), cos, sin) * (D ** -0.5)
    v = v.reshape(B, S, H, D)
    q = q.reshape(B, nc, C, H, D)
    k = k.reshape(B, nc, C, H, D)
    v = v.reshape(B, nc, C, H, D)
    log_gamma = jnp.log(1.0 - 2.0 ** (-5.0 - jnp.arange(H, dtype=jnp.float32)))
    idx = jnp.arange(C, dtype=jnp.float32)
    dif = idx[:, None] - idx[None, :]
    dmat = jnp.where(dif[None] >= 0, jnp.exp(jnp.maximum(dif, 0.0)[None] * log_gamma[:, None, None]), 0.0)
    zeta = jnp.exp((C - 1.0 - idx)[None, :] * log_gamma[:, None])
    xi = jnp.exp((idx + 1.0)[None, :] * log_gamma[:, None])
    chunk_decay = jnp.exp(C * log_gamma).astype(q.dtype)
    scores = jnp.einsum('bnihd,bnjhd->bnhij', q, k) * dmat.astype(q.dtype)[None, None]
    y_intra = jnp.einsum('bnhij,bnjhv->bnihv', scores, v)
    kv = jnp.einsum('bnjhd,bnjhv,hj->bnhdv', k, v, zeta.astype(q.dtype))

    def step(state, kv_n):
        return state * chunk_decay[None, :, None, None] + kv_n, state

    init = jnp.zeros((B, H, D, D), dtype=kv.dtype)
    _, prev = lax.scan(step, init, jnp.moveaxis(kv, 1, 0))
    prev = jnp.moveaxis(prev, 0, 1)
    y_cross = jnp.einsum('bnihd,bnhdv->bnihv', q, prev) * xi.T.astype(q.dtype)[None, None, :, :, None]
    y = (y_intra + y_cross).reshape(B, S, H, D)
    yf = y.astype(jnp.float32)
    mu = jnp.mean(yf, axis=-1, keepdims=True)
    var = jnp.mean(jnp.square(yf - mu), axis=-1, keepdims=True)
    yn = ((yf - mu) * lax.rsqrt(var + GN_EPS)).reshape(B, S, RET_WIDTH)
    yn = (yn * gn_w.astype(jnp.float32)).astype(q.dtype)
    return jax.nn.silu(g) * yn


def setup_inputs(seed: int = 0) -> dict:
    key = jax.random.key(seed)
    ks = jax.random.split(key, 16)

    def w(k, shape, fan_in):
        return jax.random.normal(k, shape, jnp.float32) * fan_in ** -0.5

    def gain(k, shape):
        return 1.0 + 0.02 * jax.random.normal(k, shape, jnp.float32)

    return {
        "x": jax.random.normal(ks[0], (BATCH, SEQ, D_MODEL), jnp.float32),
        "ffn1_norm": gain(ks[1], (DEPTH, D_MODEL)),
        "ffn1_w_gate": w(ks[2], (DEPTH, D_MODEL, D_FF), D_MODEL),
        "ffn1_w_up": w(ks[3], (DEPTH, D_MODEL, D_FF), D_MODEL),
        "ffn1_w_down": w(ks[4], (DEPTH, D_FF, D_MODEL), D_FF),
        "mix_norm": gain(ks[5], (DEPTH, D_MODEL)),
        "w_in": w(ks[6], (DEPTH, D_MODEL, D_IN), D_MODEL),
        "attn_sinks": 0.5 * jax.random.normal(ks[7], (DEPTH, N_ATTN_HEADS), jnp.float32),
        "ret_gn_w": gain(ks[8], (DEPTH, RET_WIDTH)),
        "w_out": w(ks[9], (DEPTH, D_MODEL, D_MODEL), D_MODEL),
        "ffn2_norm": gain(ks[10], (DEPTH, D_MODEL)),
        "ffn2_w_gate": w(ks[11], (DEPTH, D_MODEL, D_FF), D_MODEL),
        "ffn2_w_up": w(ks[12], (DEPTH, D_MODEL, D_FF), D_MODEL),
        "ffn2_w_down": w(ks[13], (DEPTH, D_FF, D_MODEL), D_FF),
        "final_norm": gain(ks[14], (D_MODEL,)),
    }


def reference(x, ffn1_norm, ffn1_w_gate, ffn1_w_up, ffn1_w_down, mix_norm, w_in,
              attn_sinks, ret_gn_w, w_out, ffn2_norm, ffn2_w_gate, ffn2_w_up,
              ffn2_w_down, final_norm):
    h = x
    for l in range(DEPTH):
        h = h + 0.5 * swiglu(rms_norm(h, ffn1_norm[l]), ffn1_w_gate[l], ffn1_w_up[l], ffn1_w_down[l])
        u = rms_norm(h, mix_norm[l])
        aq, ak, av, rq, rk, rv, rg = jnp.split(u @ w_in[l], IN_SPLITS, axis=-1)
        a = sliding_window_sink_attention(aq, ak, av, attn_sinks[l])
        r = multiscale_retention(rq, rk, rv, rg, ret_gn_w[l])
        h = h + jnp.concatenate([a, r], axis=-1) @ w_out[l]
        h = h + 0.5 * swiglu(rms_norm(h, ffn2_norm[l]), ffn2_w_gate[l], ffn2_w_up[l], ffn2_w_down[l])
    return rms_norm(h, final_norm)
```

```cpp
#include <hip/hip_runtime.h>
#include <hip/hip_cooperative_groups.h>
#include <cstdio>
#include <cstdint>
namespace cg = cooperative_groups;
#ifndef MK_MULTI
#define MK_MULTI 0
#endif
#ifndef PROBE_REP_MASK
#define PROBE_REP_MASK 0
#endif
namespace pg8 {
#define PG8_LAS __attribute__((address_space(3)))
typedef unsigned short bf16_t;
typedef short bf16x8 __attribute__((ext_vector_type(8)));
typedef float f32x4 __attribute__((ext_vector_type(4)));
typedef unsigned u32x4 __attribute__((ext_vector_type(4)));
constexpr int BM = 256, BK = 64, HALF = 128, HTB = HALF * BK * 2  , STAGE_BYTES = 8 * HTB, NXCD = 8, WGM = 8;

__host__ __device__ __forceinline__ int lds_byte(int r, int c) { const int st = (r >> 4) * 2 + (c >> 5), rr = r & 15, cc = c & 31, ob = rr * 64 + cc * 2; return st * 1024 + (ob ^ (((ob >> 9) & 1) << 5)); }
__host__ __device__ __forceinline__ void stage_rc(int b, int& R, int& C) { const int st = b / 1024, sb = b % 1024, swz = sb ^ (((sb >> 9) & 1) << 5); R = (st >> 1) * 16 + swz / 64; C = (st & 1) * 32 + (swz % 64) / 2; }
__host__ __device__ __forceinline__ int perm32(int rho) { const int n = rho >> 4, i = rho & 15; return 8 * (i >> 2) + 4 * n + (i & 3); }

__host__ __device__ __forceinline__ size_t a_tiled_off(int m, int c, int K) { return (size_t)(m >> 8) * 256 * K * 2 + (size_t)((c >> 6) * 2 + ((m >> 7) & 1)) * 16384 + (size_t)lds_byte(m & 127, c & 63); }
struct Unit { int pm, pn, hf; };
struct Gemm { const bf16_t* A; const bf16_t* Bt; int M, N, K; };

struct StaticOrder {
    int nM, nN, nwg, G, c;
    __host__ __device__ void init(int M, int N, int G_, int c_) { nM = M / BM; nN = N / BM; nwg = nM * nN; G = G_; c = c_; }
    __host__ __device__ bool next(int i, Unit& u) const {
        long L = (long)i * G + c; u.hf = 0;
        const int nfull = nwg / G;
        if ((G % 16 == 0) && (nwg % G == G / 2) && i >= nfull) { if (i > nfull) return false; L = (long)nfull * G + ((c >> 4) << 3) + (c & 7); u.hf = 1 + ((c >> 3) & 1); }
        else if (L >= nwg) return false;
        int wgid = (int)L; { const int q = nwg / NXCD, r = nwg % NXCD, xcd = wgid % NXCD, off = wgid / NXCD; wgid = (xcd < r ? xcd * (q + 1) : r * (q + 1) + (xcd - r) * q) + off; }
        const int nig = WGM * nN, gid = wgid / nig, fm = gid * WGM, gsz = (nM - fm) < WGM ? (nM - fm) : WGM;
        u.pm = fm + ((wgid % nig) % gsz); u.pn = (wgid % nig) / gsz; return true;
    }
    __device__ __forceinline__ void a_ready(const Unit&) const {}
    __device__ __forceinline__ void done(const Unit&) const {}
};

__device__ __forceinline__ unsigned cvt_pk_bf16(float lo, float hi) { unsigned r; asm volatile("v_cvt_pk_bf16_f32 %0, %1, %2" : "=v"(r) : "v"(lo), "v"(hi)); return r; }
typedef float f32x2 __attribute__((ext_vector_type(2)));
typedef unsigned u32x2 __attribute__((ext_vector_type(2)));
constexpr int PART_N = 16;
__device__ __forceinline__ float row_rstd(const float* part, int row, int fq) {
    const f32x4 p = *(const f32x4*)(part + (size_t)row * PART_N + 4 * fq);
    float s = (p[0] + p[1]) + (p[2] + p[3]);
    s += __shfl_xor(s, 16); s += __shfl_xor(s, 32);
    return 1.0f / sqrtf(s * (1.0f / 1024.0f) + 1e-6f);
}
__device__ __forceinline__ float silu_f(float g) { return g * __builtin_amdgcn_rcpf(1.0f + __builtin_amdgcn_exp2f(-1.44269504f * g)); }
struct EpiSwiGLU {
    static constexpr bool PERM = true, AFTER_DRAIN = false;
    bf16_t* O; int ldo; const float* part; const PG8_LAS float* rtab; int rpm, rpm2;
    __device__ __forceinline__ void operator()(const f32x4 (&acc)[2][2][4][2], const Unit& u, int wr, int wc, int fr, int fq) const {
        const int row0 = u.pm * BM + (u.hf == 2 ? HALF : 0) + wr * 64 + fr, col0 = u.pn * HALF + wc * 32 + 8 * fq;
        float rsv[2][4];
        if (u.pm == rpm || u.pm == rpm2) {
            const PG8_LAS float* rt = rtab + (u.pm == rpm ? 0 : 256);
#pragma unroll
            for (int ai = 0; ai < 2; ++ai)
#pragma unroll
                for (int m = 0; m < 4; ++m) rsv[ai][m] = rt[(row0 - u.pm * BM + ai * HALF + m * 16) & 255];
        } else {
#pragma unroll
            for (int ai = 0; ai < 2; ++ai)
#pragma unroll
                for (int m = 0; m < 4; ++m) rsv[ai][m] = row_rstd(part, row0 + ai * HALF + m * 16, fq);
        }
#pragma unroll
        for (int ai = 0; ai < 2; ++ai) {
            if (ai == 1 && u.hf) break;
#pragma unroll
            for (int m = 0; m < 4; ++m) {
                const int row = row0 + ai * HALF + m * 16; const float rs = rsv[ai][m];
                const float rsc = rs * -1.44269504f, rs2 = rs * rs;
                unsigned wv[4];
#pragma unroll
                for (int n = 0; n < 2; ++n)
#pragma unroll
                    for (int e = 0; e < 2; ++e) {
                        const f32x2 g2 = {acc[ai][0][m][n][2 * e], acc[ai][0][m][n][2 * e + 1]}, u2 = {acc[ai][1][m][n][2 * e], acc[ai][1][m][n][2 * e + 1]};
                        const f32x2 t = g2 * rsc;
                        f32x2 d; d.x = __builtin_amdgcn_exp2f(t.x); d.y = __builtin_amdgcn_exp2f(t.y);
                        d = d + 1.0f;
                        f32x2 r; r.x = __builtin_amdgcn_rcpf(d.x); r.y = __builtin_amdgcn_rcpf(d.y);
                        const f32x2 o = ((g2 * u2) * r) * rs2;
                        wv[2 * n + e] = cvt_pk_bf16(o.x, o.y);
                    }
                u32x4 w; w.x = wv[0]; w.y = wv[1]; w.z = wv[2]; w.w = wv[3];
                *(u32x4*)((unsigned char*)O + a_tiled_off(row, col0, ldo)) = w;
            }
        }
    }
};
struct EpiScaleBf16 {
    static constexpr bool PERM = true, AFTER_DRAIN = false;
    bf16_t* O; int ldo; const float* part; int gate_pn; const PG8_LAS float* rtab; int rpm;
    __device__ __forceinline__ void operator()(const f32x4 (&acc)[2][2][4][2], const Unit& u, int wr, int wc, int fr, int fq) const {
        const int row0 = u.pm * BM + wr * 64 + fr, col0 = u.pn * BM + wc * 32 + 8 * fq;
        const bool gate = u.pn >= gate_pn;
        float rsv[2][4];
        if (u.pm == rpm) {
#pragma unroll
            for (int ai = 0; ai < 2; ++ai)
#pragma unroll
                for (int m = 0; m < 4; ++m) rsv[ai][m] = rtab[(row0 - u.pm * BM + ai * HALF + m * 16) & 255];
        } else {
#pragma unroll
            for (int ai = 0; ai < 2; ++ai)
#pragma unroll
                for (int m = 0; m < 4; ++m) rsv[ai][m] = row_rstd(part, row0 + ai * HALF + m * 16, fq);
        }
#pragma unroll
        for (int ai = 0; ai < 2; ++ai)
#pragma unroll
            for (int m = 0; m < 4; ++m) {
                const int row = row0 + ai * HALF + m * 16; const float rs = rsv[ai][m];
#pragma unroll
                for (int bj = 0; bj < 2; ++bj) {
                    f32x4 v0 = acc[ai][bj][m][0] * rs, v1 = acc[ai][bj][m][1] * rs;
                    if (gate) {
                        f32x4 d0 = v0 * -1.44269504f, d1 = v1 * -1.44269504f;
#pragma unroll
                        for (int e = 0; e < 4; ++e) { d0[e] = __builtin_amdgcn_exp2f(d0[e]); d1[e] = __builtin_amdgcn_exp2f(d1[e]); }
                        d0 = d0 + 1.0f; d1 = d1 + 1.0f;
#pragma unroll
                        for (int e = 0; e < 4; ++e) { d0[e] = __builtin_amdgcn_rcpf(d0[e]); d1[e] = __builtin_amdgcn_rcpf(d1[e]); }
                        v0 = v0 * d0; v1 = v1 * d1;
                    }
                    u32x4 w; w.x = cvt_pk_bf16(v0[0], v0[1]); w.y = cvt_pk_bf16(v0[2], v0[3]); w.z = cvt_pk_bf16(v1[0], v1[1]); w.w = cvt_pk_bf16(v1[2], v1[3]);
                    *(u32x4*)(O + (size_t)row * ldo + col0 + bj * HALF) = w;
                }
            }
    }
};
struct EpiResid {
    static constexpr bool PERM = true, AFTER_DRAIN = false;
    bf16_t* hb; float* part; float scale;
    __device__ __forceinline__ void operator()(const f32x4 (&acc)[2][2][4][2], const Unit& u, int wr, int wc, int fr, int fq) const {
        const int row0 = u.pm * BM + wr * 64 + fr, col0 = u.pn * BM + wc * 32 + 8 * fq;
#pragma unroll
        for (int ai = 0; ai < 2; ++ai) {
            u32x4 bw[4][2];
#pragma unroll
            for (int m = 0; m < 4; ++m)
#pragma unroll
                for (int bj = 0; bj < 2; ++bj) bw[m][bj] = *(const u32x4*)((const unsigned char*)hb + a_tiled_off(row0 + ai * HALF + m * 16, col0 + bj * HALF, 1024));
            __builtin_amdgcn_sched_barrier(0);
#pragma unroll
            for (int m = 0; m < 4; ++m) {
                const int row = row0 + ai * HALF + m * 16; float ss = 0.f;
#pragma unroll
                for (int bj = 0; bj < 2; ++bj) {
                    const size_t off = (size_t)row * 1024 + col0 + bj * HALF;
                    const u32x4 b = bw[m][bj];
                    const f32x4 b0 = (f32x4){__uint_as_float(b.x << 16), __uint_as_float(b.x & 0xffff0000u), __uint_as_float(b.y << 16), __uint_as_float(b.y & 0xffff0000u)};
                    const f32x4 b1 = (f32x4){__uint_as_float(b.z << 16), __uint_as_float(b.z & 0xffff0000u), __uint_as_float(b.w << 16), __uint_as_float(b.w & 0xffff0000u)};
                    const f32x4 h0 = b0 + acc[ai][bj][m][0] * scale, h1 = b1 + acc[ai][bj][m][1] * scale;
                    u32x4 w; w.x = cvt_pk_bf16(h0[0], h0[1]); w.y = cvt_pk_bf16(h0[2], h0[3]); w.z = cvt_pk_bf16(h1[0], h1[1]); w.w = cvt_pk_bf16(h1[2], h1[3]);
                    *(u32x4*)((unsigned char*)hb + a_tiled_off(row, col0 + bj * HALF, 1024)) = w;
                    ss += (h0[0] * h0[0] + h0[1] * h0[1]) + (h0[2] * h0[2] + h0[3] * h0[3]) + (h1[0] * h1[0] + h1[1] * h1[1]) + (h1[2] * h1[2] + h1[3] * h1[3]);
                }
                ss += __shfl_xor(ss, 16); ss += __shfl_xor(ss, 32);
                if (fq == 0) part[(size_t)row * PART_N + u.pn * 4 + wc] = ss;
            }
            asm volatile("" ::: "memory");
        }
    }
};
template <class Epi, class Sched, bool ALIGN_EPI = false, bool SP2 = false>
__device__ __forceinline__ void gemm_phase(PG8_LAS unsigned char* lds, const Gemm g, const Sched& S, const Epi& E) {
    int tid_ = threadIdx.x; asm volatile("" : "+v"(tid_)); const int tid = tid_, wid = __builtin_amdgcn_readfirstlane(tid >> 6), lane = tid & 63, wr = wid >> 2, wc = wid & 3, fr = lane & 15, fq = lane >> 4;
    const int K = g.K, nt = K / BK;
    unsigned voffA[2], voffB[2];
#pragma unroll
    for (int i = 0; i < 2; ++i) { int R, C; stage_rc(tid * 16 + i * 8192, R, C); const int Rb = Epi::PERM ? ((R & ~31) + perm32(R & 31)) : R;
        voffA[i] = (unsigned)(tid * 16 + i * 8192); voffB[i] = voffA[i]; (void)Rb; (void)R; (void)C; }
    const size_t kstep = 32768;
    const size_t hstep = 16384;
    const size_t tstep = (size_t)256 * K * 2;
    const size_t kstepB = 32768, hstepB = 16384;
    const unsigned ldsw = (unsigned)wid * 1024u;
    const int aoff = lds_byte(wr * 64 + fr, fq * 8), boff = lds_byte(wc * 32 + fr, fq * 8);
#define PG8_SA(b, h) (((b) * 2 + (h)) * HTB)
#define PG8_SB(b, h) ((4 + (b) * 2 + (h)) * HTB)
#define PG8_STAGE(bufoff, gbase, voff) do { _Pragma("unroll") for (int _i = 0; _i < 2; ++_i) \
        __builtin_amdgcn_global_load_lds((const unsigned*)((const char*)(gbase) + (voff)[_i]), (PG8_LAS unsigned*)(lds + (bufoff) + ldsw + _i * 8192), 16, 0, 0); } while (0)
#define PG8_LDA(dst, b, h) do { _Pragma("unroll") for (int m = 0; m < 4; ++m) _Pragma("unroll") for (int k = 0; k < 2; ++k) dst[m][k] = *(const PG8_LAS bf16x8*)(lds + PG8_SA(b, h) + aoff + m * 2048 + k * 1024); } while (0)
#define PG8_LDB(dst, b, h) do { _Pragma("unroll") for (int n = 0; n < 2; ++n) _Pragma("unroll") for (int k = 0; k < 2; ++k) dst[n][k] = *(const PG8_LAS bf16x8*)(lds + PG8_SB(b, h) + boff + n * 2048 + k * 1024); } while (0)
#define PG8_MMA(ai, bj, At, Bt) do { __builtin_amdgcn_s_setprio(1); _Pragma("unroll") for (int m = 0; m < 4; ++m) _Pragma("unroll") for (int n = 0; n < 2; ++n) _Pragma("unroll") for (int k = 0; k < 2; ++k) \
        acc[ai][bj][m][n] = __builtin_amdgcn_mfma_f32_16x16x32_bf16(Bt[n][k], At[m][k], acc[ai][bj][m][n], 0, 0, 0); __builtin_amdgcn_s_setprio(0); } while (0)
#define PG8_WAIT_V(n) asm volatile("s_waitcnt vmcnt(" #n ")" ::: "memory")
#define PG8_WAIT_L(n) asm volatile("s_waitcnt lgkmcnt(" #n ")" ::: "memory")
#define PG8_BAR __builtin_amdgcn_s_barrier()
#define PG8_SCHED __builtin_amdgcn_sched_barrier(0)
    Unit cur, nxt; int ui = 0;
    if (!S.next(0, cur)) return;
    f32x4 acc[2][2][4][2];
#pragma unroll
    for (int a = 0; a < 2; ++a)
#pragma unroll
        for (int b = 0; b < 2; ++b)
#pragma unroll
            for (int m = 0; m < 4; ++m)
#pragma unroll
                for (int n = 0; n < 2; ++n) acc[a][b][m][n] = (f32x4){0.f, 0.f, 0.f, 0.f};
    bf16x8 At[4][2], B0[2][2], B1[2][2];
    const char* cA = (const char*)g.A + (size_t)cur.pm * tstep + (cur.hf == 2 ? hstep : (size_t)0); const char* cB = (const char*)g.Bt + (size_t)cur.pn * tstep;
    S.a_ready(cur);
    if constexpr (SP2) {
        PG8_STAGE(PG8_SB(0, 0), cB, voffB); PG8_STAGE(PG8_SB(0, 1), cB + hstepB, voffB); PG8_STAGE(PG8_SA(0, 0), cA, voffA); PG8_STAGE(PG8_SA(0, 1), cA + hstep, voffA);
        if (wr == 1) PG8_BAR;
        PG8_WAIT_V(2); PG8_BAR;
        PG8_STAGE(PG8_SB(1, 0), cB + kstepB, voffB); PG8_STAGE(PG8_SA(1, 0), cA + kstep, voffA); PG8_STAGE(PG8_SB(1, 1), cB + hstepB + kstepB, voffB);
        PG8_WAIT_V(6); PG8_BAR;
    } else {
        PG8_STAGE(PG8_SB(0, 0), cB, voffB); PG8_STAGE(PG8_SA(0, 0), cA, voffA); PG8_STAGE(PG8_SB(0, 1), cB + hstepB, voffB); PG8_STAGE(PG8_SA(0, 1), cA + hstep, voffA);
        if (wr == 1) PG8_BAR;
        PG8_WAIT_V(4); PG8_BAR;
        PG8_STAGE(PG8_SB(1, 0), cB + kstepB, voffB); PG8_STAGE(PG8_SA(1, 0), cA + kstep, voffA); PG8_STAGE(PG8_SB(1, 1), cB + hstepB + kstepB, voffB);
        PG8_WAIT_V(6); PG8_BAR;
    }
    for (;;) {
        const bool has_next = S.next(ui + 1, nxt);
        const char* nA = has_next ? (const char*)g.A + (size_t)nxt.pm * tstep + (nxt.hf == 2 ? hstep : (size_t)0) : cA; const char* nB = has_next ? (const char*)g.Bt + (size_t)nxt.pn * tstep : cB;
        for (int t = 0; t < nt; t += 2) {
            const bool last = (t == nt - 2);
            const char* a1 = cA + (size_t)(t + 1) * kstep;
            const char* a2 = last ? nA : cA + (size_t)(t + 2) * kstep; const char* b2 = last ? nB : cB + (size_t)(t + 2) * kstepB;
            const char* a3 = a2 + kstep; const char* b3 = b2 + kstepB;
            if (last && has_next) S.a_ready(nxt);
            if constexpr (SP2) {
            PG8_LDB(B0, 0, 0); PG8_LDB(B1, 0, 1); PG8_SCHED; PG8_LDA(At, 0, 0); PG8_STAGE(PG8_SA(1, 1), a1 + hstep, voffA);
            PG8_WAIT_V(8); PG8_WAIT_L(0); PG8_BAR; PG8_MMA(0, 0, At, B0); PG8_MMA(0, 1, At, B1); PG8_BAR; PG8_SCHED;
            PG8_LDA(At, 0, 1); PG8_STAGE(PG8_SB(0, 0), b2, voffB); PG8_STAGE(PG8_SB(0, 1), b2 + hstepB, voffB); PG8_STAGE(PG8_SA(0, 0), a2, voffA);
            PG8_WAIT_V(8); PG8_WAIT_L(0); PG8_BAR; if (!cur.hf) { PG8_MMA(1, 0, At, B0); PG8_MMA(1, 1, At, B1); } PG8_BAR; PG8_SCHED;
            PG8_LDB(B0, 1, 0); PG8_LDB(B1, 1, 1); PG8_SCHED; PG8_LDA(At, 1, 0); PG8_STAGE(PG8_SA(0, 1), a2 + hstep, voffA);
            PG8_WAIT_V(8); PG8_WAIT_L(0); PG8_BAR; PG8_MMA(0, 0, At, B0); PG8_MMA(0, 1, At, B1); PG8_BAR; PG8_SCHED;
            PG8_LDA(At, 1, 1); PG8_STAGE(PG8_SB(1, 0), b3, voffB); PG8_STAGE(PG8_SB(1, 1), b3 + hstepB, voffB); PG8_STAGE(PG8_SA(1, 0), a3, voffA);
            PG8_WAIT_V(8); PG8_WAIT_L(0); PG8_BAR; if (!cur.hf) { PG8_MMA(1, 0, At, B0); PG8_MMA(1, 1, At, B1); } PG8_BAR; PG8_SCHED;
            } else {
            PG8_LDB(B0, 0, 0); PG8_SCHED; PG8_LDA(At, 0, 0); PG8_STAGE(PG8_SA(1, 1), a1 + hstep, voffA);
            PG8_WAIT_L(8); PG8_BAR; PG8_WAIT_L(0); PG8_MMA(0, 0, At, B0); PG8_BAR; PG8_SCHED;
            PG8_LDB(B1, 0, 1); PG8_STAGE(PG8_SB(0, 0), b2, voffB);
            PG8_BAR; PG8_WAIT_L(0); PG8_MMA(0, 1, At, B1); PG8_BAR;
            PG8_LDA(At, 0, 1); PG8_STAGE(PG8_SA(0, 0), a2, voffA);
            PG8_BAR; PG8_WAIT_L(0); PG8_MMA(1, 0, At, B0); PG8_BAR; PG8_SCHED;
            PG8_STAGE(PG8_SB(0, 1), b2 + hstepB, voffB);
            PG8_WAIT_V(6); PG8_BAR; PG8_MMA(1, 1, At, B1); PG8_BAR;
            PG8_LDB(B0, 1, 0); PG8_SCHED; PG8_LDA(At, 1, 0); PG8_STAGE(PG8_SA(0, 1), a2 + hstep, voffA);
            PG8_WAIT_L(8); PG8_BAR; PG8_WAIT_L(0); PG8_MMA(0, 0, At, B0); PG8_BAR; PG8_SCHED;
            PG8_LDB(B1, 1, 1); PG8_STAGE(PG8_SB(1, 0), b3, voffB);
            PG8_BAR; PG8_WAIT_L(0); PG8_MMA(0, 1, At, B1); PG8_BAR;
            PG8_LDA(At, 1, 1); PG8_STAGE(PG8_SA(1, 0), a3, voffA);
            PG8_BAR; PG8_WAIT_L(0); PG8_MMA(1, 0, At, B0); PG8_BAR; PG8_SCHED;
            PG8_STAGE(PG8_SB(1, 1), b3 + hstepB, voffB);
            PG8_WAIT_V(6); PG8_BAR; PG8_MMA(1, 1, At, B1); PG8_BAR;
            }
        }
        if constexpr (ALIGN_EPI) { if (wr == 0) PG8_BAR; }
        if constexpr (!Epi::AFTER_DRAIN) { E(acc, cur, wr, wc, fr, fq); S.done(cur); }
        if (!has_next) break;
#pragma unroll
        for (int a = 0; a < 2; ++a)
#pragma unroll
            for (int b = 0; b < 2; ++b)
#pragma unroll
                for (int m = 0; m < 4; ++m)
#pragma unroll
                    for (int n = 0; n < 2; ++n) acc[a][b][m][n] = (f32x4){0.f, 0.f, 0.f, 0.f};
        cur = nxt; cA = nA; cB = nB; ++ui;
        if constexpr (ALIGN_EPI) { if (wr == 1) PG8_BAR; }
    }
    PG8_WAIT_V(0);
    if constexpr (!ALIGN_EPI) { if (wr == 0) PG8_BAR; }
    PG8_BAR;
    if constexpr (Epi::AFTER_DRAIN) { E.fused(acc, cur, wr, wc, fr, fq, lds, wid, lane); S.done(cur); }
#undef PG8_SA
#undef PG8_SB
#undef PG8_STAGE
#undef PG8_LDA
#undef PG8_LDB
#undef PG8_MMA
#undef PG8_WAIT_V
#undef PG8_WAIT_L
#undef PG8_BAR
#undef PG8_SCHED
}
}
constexpr int NWAVES = 8;
constexpr int BATCH = 8, SEQ = 2048, DM = 1024, FF = 2816, DIN = 2816, DEPTH = 4;
constexpr int M = BATCH * SEQ;
constexpr int NPH = 2 + 9 * DEPTH;
constexpr size_t MiB = 1u << 20;
constexpr size_t WS_CTL = 0, CTL_ZERO_BYTES = 32768;
constexpr size_t WS_ROPE = 1 * MiB;
constexpr size_t WS_PART = 2 * MiB;
constexpr size_t WS_W = 4 * MiB;
constexpr size_t E_GU = (size_t)2 * FF * DM, E_DN = (size_t)DM * FF, E_IN = (size_t)DIN * DM, E_OUT = (size_t)DM * DM;
constexpr size_t O_GU1 = 0, O_D1 = E_GU, O_IN = O_D1 + E_DN, O_OUT = O_IN + E_IN, O_GU2 = O_OUT + E_OUT, O_D2 = O_GU2 + E_GU, L_STRIDE = O_D2 + E_DN;
constexpr size_t WS_HB = 166 * MiB;
constexpr size_t WS_ACT = 198 * MiB;
constexpr size_t WS_MIX = 286 * MiB;
constexpr size_t WS_KV = 318 * MiB;
constexpr size_t WS_PREV = 350 * MiB;
constexpr size_t WS_END = 366 * MiB;
static_assert(WS_W + DEPTH * L_STRIDE * 2 <= WS_HB, "weights fit");
constexpr int LDS_BYTES = 147456, LDS_BARST = LDS_BYTES - 64;

#define LAS __attribute__((address_space(3)))
typedef unsigned short bf16;
typedef float f32x4 __attribute__((ext_vector_type(4)));
typedef short bf16x8 __attribute__((ext_vector_type(8)));
typedef short s16x4 __attribute__((ext_vector_type(4)));
typedef unsigned u32x4 __attribute__((ext_vector_type(4)));
typedef unsigned u32x2 __attribute__((ext_vector_type(2)));
#define LDS_WAIT() asm volatile("s_waitcnt lgkmcnt(0)" ::: "memory")
#define MFMA16(a, b, c) __builtin_amdgcn_mfma_f32_16x16x32_bf16((a), (b), (c), 0, 0, 0)
__device__ __forceinline__ unsigned f2bf(float f) { unsigned u = __float_as_uint(f); return (u + 0x7fffu + ((u >> 16) & 1u)) >> 16; }
typedef float f32x2_t __attribute__((ext_vector_type(2)));
typedef __bf16 bf16x2_t __attribute__((ext_vector_type(2)));
__device__ __forceinline__ unsigned pk2(float lo, float hi) { const f32x2_t v = {lo, hi}; return __builtin_bit_cast(unsigned, __builtin_convertvector(v, bf16x2_t)); }
__device__ __forceinline__ float bflo(unsigned w) { return __uint_as_float(w << 16); }
__device__ __forceinline__ float bfhi(unsigned w) { return __uint_as_float(w & 0xffff0000u); }
__device__ __forceinline__ float wave_sum(float v) {
#pragma unroll
    for (int o = 1; o < 64; o <<= 1) v += __shfl_xor(v, o);
    return v;
}

#define XB_TMO      128
#define XB_XCNT(j)  (256  + 64 * (j))
#define XB_XSUB(j)  (1280 + 64 * (j))
#define XB_XGEN(j)  (2304 + 64 * (j))
#define XB_TOP      3328
#define XB_TOPGEN   3392
#define XCD_BAR_WORDS 3456
#define XB_SPIN_CAP (1u << 18)

__device__ __forceinline__ unsigned xb_ld(unsigned* p)              { return __hip_atomic_load(p, __ATOMIC_RELAXED, __HIP_MEMORY_SCOPE_AGENT); }
__device__ __forceinline__ unsigned xb_add(unsigned* p, unsigned v) { return __hip_atomic_fetch_add(p, v, __ATOMIC_RELAXED, __HIP_MEMORY_SCOPE_AGENT); }
__device__ __forceinline__ unsigned xb_xcc_id() { return (unsigned)__builtin_amdgcn_s_getreg((3 << 11) | 20) & 0xFu; }
#define XB_SPIN(cond, bar) do { unsigned _sp = 0; while (cond) { __builtin_amdgcn_s_sleep(1); \
    if ((++_sp & 255u) == 0u) { if (xb_ld(&(bar)[XB_TMO])) break; if (_sp > XB_SPIN_CAP) { atomicAdd(&(bar)[XB_TMO], 1u); break; } } } } while (0)

struct XcdBarrier {
    unsigned* bar; unsigned x;
    volatile LAS unsigned* st;
};

__device__ __forceinline__ XcdBarrier xcd_barrier_post(unsigned* bar, volatile LAS unsigned* st) {
    XcdBarrier b; b.bar = bar; b.x = xb_xcc_id(); b.st = st;
    if (threadIdx.x == 0) (void)xb_add(&bar[XB_XCNT(b.x)], 1u);
    return b;
}
__device__ __forceinline__ void xcd_barrier_complete(unsigned* bar, unsigned x, unsigned& nloc, unsigned& nx) {
    const unsigned G = gridDim.x * gridDim.y * gridDim.z;
    unsigned sum, cnt, mine, sp = 0u;
    for (;;) {
        sum = 0u; cnt = 0u; mine = 0u;
#pragma unroll
        for (unsigned j = 0; j < 16; ++j) { const unsigned c = xb_ld(&bar[XB_XCNT(j)]); sum += c; cnt += (c > 0u) ? 1u : 0u; mine = (j == x) ? c : mine; }
        if (sum == G) break;
        __builtin_amdgcn_s_sleep(1);
        if ((++sp & 255u) == 0u) { if (xb_ld(&bar[XB_TMO])) break; if (sp > XB_SPIN_CAP) { atomicAdd(&bar[XB_TMO], 1u); break; } }
    }
    nloc = mine > 0u ? mine : 1u; nx = cnt > 0u ? cnt : 1u;
}

__device__ __forceinline__ void xcd_barrier(const XcdBarrier& b) {
    asm volatile("s_waitcnt vmcnt(0)" ::: "memory");
    __syncthreads();
    if (threadIdx.x == 0) {
        unsigned* bar = b.bar;
        __builtin_amdgcn_s_waitcnt(0);
        unsigned nloc = b.st[0], nx = b.st[1];
        if (nloc == 0u) { xcd_barrier_complete(bar, b.x, nloc, nx); b.st[0] = nloc; b.st[1] = nx; }
        const unsigned old = xb_add(&bar[XB_XSUB(b.x)], 1u);
        const unsigned gen = old / nloc;
        if (old + 1u == (gen + 1u) * nloc) {
            __builtin_amdgcn_fence(__ATOMIC_RELEASE, "agent");
            asm volatile("s_waitcnt vmcnt(0)" ::: "memory");
            const unsigned og = xb_add(&bar[XB_TOP], 1u);
            const unsigned tg = og / nx;
            if (og + 1u == (tg + 1u) * nx) xb_add(&bar[XB_TOPGEN], 1u);
            else XB_SPIN(xb_ld(&bar[XB_TOPGEN]) == tg, bar);
            __builtin_amdgcn_fence(__ATOMIC_ACQUIRE, "agent");
            xb_add(&bar[XB_XGEN(b.x)], 1u);
            asm volatile("s_waitcnt vmcnt(0)" ::: "memory");
        } else {
            XB_SPIN(xb_ld(&bar[XB_XGEN(b.x)]) == gen, bar);
            __builtin_amdgcn_fence(__ATOMIC_ACQUIRE, "agent");
            asm volatile("s_waitcnt vmcnt(0)" ::: "memory");
        }
    }
    __syncthreads();
}
#define XL_CNT(j) (4096 + 64 * (j))
#define XL_GEN(j) (5120 + 64 * (j))
__device__ __forceinline__ void xcd_local_barrier(unsigned* bar, unsigned x, unsigned nloc) {
    asm volatile("s_waitcnt vmcnt(0)" ::: "memory");
    __syncthreads();
    if (threadIdx.x == 0) {
        __builtin_amdgcn_s_waitcnt(0);
        const unsigned old = xb_add(&bar[XL_CNT(x)], 1u);
        const unsigned gen = old / nloc;
        if (old + 1u == (gen + 1u) * nloc) xb_add(&bar[XL_GEN(x)], 1u);
        else XB_SPIN(xb_ld(&bar[XL_GEN(x)]) == gen, bar);
        __builtin_amdgcn_fence(__ATOMIC_ACQUIRE, "agent");
        asm volatile("s_waitcnt vmcnt(0)" ::: "memory");
    }
    __syncthreads();
}
struct Args { const float* in[15]; float* out; unsigned char* ws; int ph_lo, ph_hi, use_sync, pad; };

__device__ __forceinline__ size_t bt_tiled_off(int rho, int k, int K) {
    const int pn = rho >> 8, rr = rho & 255, h = rr >> 7, r128 = rr & 127;
    const int x = r128 & 31, R = (r128 & ~31) + 16 * ((x >> 2) & 1) + 4 * (x >> 3) + (x & 3);
    return (size_t)pn * 256 * K * 2 + (size_t)((k >> 6) * 2 + h) * 16384 + (size_t)pg8::lds_byte(R, k & 63);
}
__device__ __forceinline__ void tr_item(const float* W, int K, int N, bf16* WT, int kb, int nb, int row_base, const float* kscale, LAS float* scr, int lane) {
    const int k0 = 64 * kb, n0 = 64 * nb;
    f32x4 v[16]; float sc[16];
#pragma unroll
    for (int i = 0; i < 16; ++i) {
        const int kk = 4 * i + (lane >> 4);
        v[i] = *(const f32x4*)(W + (size_t)(k0 + kk) * N + n0 + 4 * (lane & 15));
        sc[i] = kscale ? kscale[k0 + kk] : 1.0f;
    }
#pragma unroll
    for (int i = 0; i < 16; ++i) {
        const int kk = 4 * i + (lane >> 4);
        LAS float* d = scr + kk * 65 + 4 * (lane & 15);
        d[0] = v[i][0] * sc[i]; d[1] = v[i][1] * sc[i]; d[2] = v[i][2] * sc[i]; d[3] = v[i][3] * sc[i];
    }
    LDS_WAIT();
    const int c = lane & 7;
#pragma unroll
    for (int j = 0; j < 8; ++j) {
        const int n = (lane >> 3) + 8 * j; const LAS float* s = scr + (8 * c) * 65 + n;
        u32x4 o; o.x = pk2(s[0 * 65], s[1 * 65]); o.y = pk2(s[2 * 65], s[3 * 65]); o.z = pk2(s[4 * 65], s[5 * 65]); o.w = pk2(s[6 * 65], s[7 * 65]);
        *(u32x4*)((unsigned char*)WT + bt_tiled_off(row_base + n, k0 + 8 * c, K)) = o;
    }
    LDS_WAIT();
}
__device__ __forceinline__ void prologue(const Args& a, LAS unsigned char* lds, int tid) {
    const int lane = tid & 63, wave = tid >> 6;
    const int gw = blockIdx.x * NWAVES + wave, NGW = gridDim.x * NWAVES;
    LAS float* scr = (LAS float*)(lds + wave * 16640);
    bf16* wbase = (bf16*)(a.ws + WS_W);
    constexpr int I_UP = 4 * 22, I_DN = 11 * 8, I_OUT = 4 * 8;
    constexpr int PER_LAYER = 7 * I_UP + I_OUT;
    const int kq = wave & 3, nh = wave >> 2;
    for (int it = blockIdx.x; it < DEPTH * PER_LAYER; it += gridDim.x) {
        const int l = it / PER_LAYER; int r = it % PER_LAYER;
        bf16* wl = wbase + (size_t)l * L_STRIDE;
        if (r < 2 * I_UP) { const int up = r >= I_UP; r -= up * I_UP; const int kb = 4 * (r / 22) + kq, nb = 2 * (r % 22) + nh, n0 = 64 * nb;
            tr_item(a.in[up ? 3 : 2] + (size_t)l * DM * FF, DM, FF, wl + O_GU1, kb, nb, 256 * (n0 >> 7) + (n0 & 127) + 128 * up, a.in[1] + l * DM, scr, lane); continue; }
        r -= 2 * I_UP;
        if (r < I_DN) { const int kb = 4 * (r / 8) + kq, nb = 2 * (r % 8) + nh; tr_item(a.in[4] + (size_t)l * FF * DM, FF, DM, wl + O_D1, kb, nb, 64 * nb, nullptr, scr, lane); continue; }
        r -= I_DN;
        if (r < I_UP) { const int kb = 4 * (r / 22) + kq, nb = 2 * (r % 22) + nh; tr_item(a.in[6] + (size_t)l * DM * DIN, DM, DIN, wl + O_IN, kb, nb, 64 * nb, a.in[5] + l * DM, scr, lane); continue; }
        r -= I_UP;
        if (r < I_OUT) { const int kb = 4 * (r / 8) + kq, nb = 2 * (r % 8) + nh; tr_item(a.in[9] + (size_t)l * DM * DM, DM, DM, wl + O_OUT, kb, nb, 64 * nb, nullptr, scr, lane); continue; }
        r -= I_OUT;
        if (r < 2 * I_UP) { const int up = r >= I_UP; r -= up * I_UP; const int kb = 4 * (r / 22) + kq, nb = 2 * (r % 22) + nh, n0 = 64 * nb;
            tr_item(a.in[up ? 12 : 11] + (size_t)l * DM * FF, DM, FF, wl + O_GU2, kb, nb, 256 * (n0 >> 7) + (n0 & 127) + 128 * up, a.in[10] + l * DM, scr, lane); continue; }
        r -= 2 * I_UP;
        { const int kb = 4 * (r / 8) + kq, nb = 2 * (r % 8) + nh; tr_item(a.in[13] + (size_t)l * FF * DM, FF, DM, wl + O_D2, kb, nb, 64 * nb, nullptr, scr, lane); }
    }
    bf16* hb = (bf16*)(a.ws + WS_HB); float* part = (float*)(a.ws + WS_PART);
    for (int m = gw; m < M; m += NGW) {
        const f32x4* xr = (const f32x4*)(a.in[0] + (size_t)m * DM) + lane; u32x2* o8 = (u32x2*)(hb + (size_t)m * DM) + lane;
        float s = 0.f;
#pragma unroll
        for (int j = 0; j < 4; ++j) { const f32x4 v = xr[64 * j]; s += (v[0] * v[0] + v[1] * v[1]) + (v[2] * v[2] + v[3] * v[3]); u32x2 w; w.x = pk2(v[0], v[1]); w.y = pk2(v[2], v[3]); *(u32x2*)((unsigned char*)hb + pg8::a_tiled_off(m, 4 * (lane + 64 * j), DM)) = w; }
        s = wave_sum(s);
        if (lane < 16) part[(size_t)m * 16 + lane] = lane == 0 ? s : 0.f;
    }
    float* rc = (float*)(a.ws + WS_ROPE); float* rsn = rc + SEQ * 64;
    for (int i = blockIdx.x * 512 + tid; i < SEQ * 64; i += gridDim.x * 512) {
        const int pos = i >> 6, d = i & 63;
        const float inv = powf(10000.0f, -(float)(2 * d) / 128.0f);
        const float ang = (float)pos * inv;
        double t = (double)ang * 0.15915494309189535; t -= rint(t);
        const float rev = (float)t;
        rc[i] = __builtin_amdgcn_cosf(rev); rsn[i] = __builtin_amdgcn_sinf(rev);
    }
}

typedef short v4i16_t __attribute__((ext_vector_type(4)));
__device__ __forceinline__ s16x4 vtr(const LAS unsigned char* p) { return __builtin_bit_cast(s16x4, __builtin_amdgcn_ds_read_tr16_b64_v4i16((LAS v4i16_t*)p)); }
__device__ __forceinline__ bf16x8 tr_frag(const LAS unsigned char* p0, const LAS unsigned char* p1) { const s16x4 lo = vtr(p0), hi = vtr(p1); return __builtin_shufflevector(lo, hi, 0, 1, 2, 3, 4, 5, 6, 7); }

constexpr int ATT_KP = 144, ATT_VP = 160;
__device__ __forceinline__ void att_unit(LAS unsigned char* lds, const bf16* proj, bf16* mix, const float* sinks, int unit, int tid) {
    const int kvh = unit & 1, nblk = (unit >> 1) & 15, b = unit >> 5, t0 = b * SEQ + nblk * 128;
    LAS unsigned char* Kimg = lds; LAS unsigned char* Vimg = lds + 256 * ATT_KP;
    const int w = tid >> 6, lane = tid & 63, fr = lane & 15, fq = lane >> 4;
    const int head = kvh * 4 + (w >> 1), half = w & 1;
    u32x4 kk[4], vv[4];
#pragma unroll
    for (int i = 0; i < 4; ++i) {
        const int idx = tid + 512 * i, key = idx >> 3, ch = idx & 7;
        kk[i] = (u32x4){0u, 0u, 0u, 0u}; vv[i] = (u32x4){0u, 0u, 0u, 0u};
        if (nblk > 0 || key >= 128) { const bf16* rp = proj + (size_t)(t0 - 128 + key) * DIN + kvh * 64 + 8 * ch; kk[i] = *(const u32x4*)(rp + 512); vv[i] = *(const u32x4*)(rp + 640); }
    }
    const bf16* qbase = proj + (size_t)(t0 + 64 * half + fr) * DIN + head * 64 + 8 * fq;
    bf16x8 qn0 = *(const bf16x8*)qbase, qn1 = *(const bf16x8*)(qbase + 32);
    const float sink = sinks[head];
    __builtin_amdgcn_sched_barrier(0);
#pragma unroll
    for (int i = 0; i < 4; ++i) {
        const int idx = tid + 512 * i, key = idx >> 3, ch = idx & 7;
        *(LAS u32x4*)(Kimg + key * ATT_KP + 16 * ch) = kk[i]; *(LAS u32x4*)(Vimg + key * ATT_VP + 16 * ch) = vv[i];
    }
    __syncthreads();
    const int trofs = (fr >> 2) * ATT_VP + 8 * (fr & 3);
    for (int mt = 0; mt < 4; ++mt) {
        const int q0 = 64 * half + 16 * mt;
        const bf16x8 qf0 = qn0, qf1 = qn1;
        if (mt < 3) { const bf16* qp = qbase + (size_t)(16 * (mt + 1)) * DIN; qn0 = *(const bf16x8*)qp; qn1 = *(const bf16x8*)(qp + 32); }
        __builtin_amdgcn_sched_barrier(0);
        f32x4 s[9];
#pragma unroll
        for (int kt = 0; kt < 9; ++kt) {
            const LAS unsigned char* kp = Kimg + (q0 + 16 * kt + fr) * ATT_KP + 16 * fq;
            const bf16x8 k0 = *(const LAS bf16x8*)kp, k1 = *(const LAS bf16x8*)(kp + 64);
            f32x4 c = (f32x4){0.f, 0.f, 0.f, 0.f};
            c = MFMA16(k0, qf0, c); c = MFMA16(k1, qf1, c); s[kt] = c;
        }
        const int qi = q0 + fr;
        float mx = sink;
#pragma unroll
        for (int kt = 0; kt < 9; ++kt) {
            const bool tile_ok = (nblk > 0) || (q0 + 16 * kt >= 128);
#pragma unroll
            for (int r = 0; r < 4; ++r) {
                const bool ok = tile_ok && (kt == 0 ? (4 * fq + r > fr) : (kt == 8 ? (4 * fq + r <= fr) : true));
                const float v = ok ? s[kt][r] * 0.125f : -1e30f;
                s[kt][r] = v; mx = fmaxf(mx, v);
            }
        }
        mx = fmaxf(mx, __shfl_xor(mx, 16)); mx = fmaxf(mx, __shfl_xor(mx, 32));
        float sum = 0.f;
#pragma unroll
        for (int kt = 0; kt < 9; ++kt)
#pragma unroll
            for (int r = 0; r < 4; ++r) { const float p = __expf(s[kt][r] - mx); s[kt][r] = p; sum += p; }
        sum += __shfl_xor(sum, 16); sum += __shfl_xor(sum, 32);
        const float inv = 1.0f / (sum + __expf(sink - mx));
        f32x4 o[4];
#pragma unroll
        for (int dt = 0; dt < 4; ++dt) o[dt] = (f32x4){0.f, 0.f, 0.f, 0.f};
#pragma unroll
        for (int p = 0; p < 5; ++p) {
            u32x4 pw; pw.x = pk2(s[2 * p][0] * inv, s[2 * p][1] * inv); pw.y = pk2(s[2 * p][2] * inv, s[2 * p][3] * inv);
            if (p < 4) { pw.z = pk2(s[2 * p + 1][0] * inv, s[2 * p + 1][1] * inv); pw.w = pk2(s[2 * p + 1][2] * inv, s[2 * p + 1][3] * inv); } else { pw.z = 0u; pw.w = 0u; }
            const bf16x8 pb = __builtin_bit_cast(bf16x8, pw);
#pragma unroll
            for (int dt = 0; dt < 4; ++dt) {
                const LAS unsigned char* vp = Vimg + (q0 + 32 * p + 4 * fq) * ATT_VP + 32 * dt + trofs;
                const s16x4 lo = vtr(vp); s16x4 hi = (s16x4){0, 0, 0, 0}; if (p < 4) hi = vtr(vp + 16 * ATT_VP);
                o[dt] = MFMA16(__builtin_shufflevector(lo, hi, 0, 1, 2, 3, 4, 5, 6, 7), pb, o[dt]);
            }
        }
        bf16* op = mix + (size_t)(t0 + q0 + fr) * DM + head * 64 + 4 * fq;
#pragma unroll
        for (int dt = 0; dt < 4; ++dt) { u32x2 w2; w2.x = pk2(o[dt][0], o[dt][1]); w2.y = pk2(o[dt][2], o[dt][3]); *(u32x2*)((unsigned char*)mix + pg8::a_tiled_off(t0 + q0 + fr, head * 64 + 16 * dt + 4 * fq, DM)) = w2; }
    }
    __syncthreads();
}

__device__ __forceinline__ float ret_log_gamma(int h) { return logf(1.0f - exp2f(-5.0f - (float)h)); }
constexpr int RET_P = 288;
template <bool ZETA>
__device__ __forceinline__ void ret_load_kv(LAS unsigned char* Kimg, LAS unsigned char* Vimg, const bf16* proj, const float* rc, const float* rsn, int t0, int n, int h, float lg, int tid) {
    u32x4 klo[2], khi[2], vv[4]; f32x4 kc[2][2], ks_[2][2];
#pragma unroll
    for (int i = 0; i < 2; ++i) {
        const int idx = tid + 512 * i, j = idx >> 3, dc = idx & 7;
        const bf16* kp = proj + (size_t)(t0 + j) * DIN + 1280 + h * 128 + 8 * dc;
        klo[i] = *(const u32x4*)kp; khi[i] = *(const u32x4*)(kp + 64);
        const int pos = n * 128 + j;
        kc[i][0] = *(const f32x4*)(rc + pos * 64 + 8 * dc); kc[i][1] = *(const f32x4*)(rc + pos * 64 + 8 * dc + 4);
        ks_[i][0] = *(const f32x4*)(rsn + pos * 64 + 8 * dc); ks_[i][1] = *(const f32x4*)(rsn + pos * 64 + 8 * dc + 4);
    }
#pragma unroll
    for (int i = 0; i < 4; ++i) { const int idx = tid + 512 * i, j = idx >> 4, vc = idx & 15; vv[i] = *(const u32x4*)(proj + (size_t)(t0 + j) * DIN + 1792 + h * 128 + 8 * vc); }
    __builtin_amdgcn_sched_barrier(0);
#pragma unroll
    for (int i = 0; i < 2; ++i) {
        const int idx = tid + 512 * i, j = idx >> 3, dc = idx & 7;
        const float ksc = ZETA ? 0.08838834764831845f : 0.08838834764831845f * __expf(-(float)j * lg);
        float r1[8], r2[8];
#pragma unroll
        for (int e = 0; e < 8; ++e) {
            const float x1 = (e & 1) ? bfhi(klo[i][e >> 1]) : bflo(klo[i][e >> 1]), x2 = (e & 1) ? bfhi(khi[i][e >> 1]) : bflo(khi[i][e >> 1]);
            const float c = kc[i][e >> 2][e & 3], sn = ks_[i][e >> 2][e & 3];
            r1[e] = (x1 * c - x2 * sn) * ksc; r2[e] = (x1 * sn + x2 * c) * ksc;
        }
        u32x4 w1, w2; w1.x = pk2(r1[0], r1[1]); w1.y = pk2(r1[2], r1[3]); w1.z = pk2(r1[4], r1[5]); w1.w = pk2(r1[6], r1[7]);
        w2.x = pk2(r2[0], r2[1]); w2.y = pk2(r2[2], r2[3]); w2.z = pk2(r2[4], r2[5]); w2.w = pk2(r2[6], r2[7]);
        *(LAS u32x4*)(Kimg + j * RET_P + 16 * dc) = w1; *(LAS u32x4*)(Kimg + j * RET_P + 128 + 16 * dc) = w2;
    }
#pragma unroll
    for (int i = 0; i < 4; ++i) {
        const int idx = tid + 512 * i, j = idx >> 4, vc = idx & 15;
        u32x4 v = vv[i];
        if (ZETA) { const float z = __expf((float)(127 - j) * lg);
            v.x = pk2(bflo(v.x) * z, bfhi(v.x) * z); v.y = pk2(bflo(v.y) * z, bfhi(v.y) * z); v.z = pk2(bflo(v.z) * z, bfhi(v.z) * z); v.w = pk2(bflo(v.w) * z, bfhi(v.w) * z); }
        *(LAS u32x4*)(Vimg + j * RET_P + 16 * vc) = v;
    }
}
__device__ __forceinline__ void r1_unit(LAS unsigned char* lds, const bf16* proj, float* kv, const float* rc, const float* rsn, int unit, int tid) {
    const int h = unit & 3, n = (unit >> 2) & 15, b = unit >> 6, t0 = b * SEQ + n * 128;
    LAS unsigned char* Kimg = lds; LAS unsigned char* Vimg = lds + 128 * RET_P;
    const float lg = ret_log_gamma(h);
    ret_load_kv<true>(Kimg, Vimg, proj, rc, rsn, t0, n, h, lg, tid);
    __syncthreads();
    const int w = tid >> 6, lane = tid & 63, fr = lane & 15, fq = lane >> 4;
    const int trofs = (fr >> 2) * RET_P + 8 * (fr & 3);
    f32x4 acc[8];
#pragma unroll
    for (int dt = 0; dt < 8; ++dt) acc[dt] = (f32x4){0.f, 0.f, 0.f, 0.f};
#pragma unroll
    for (int ks = 0; ks < 4; ++ks) {
        const int rb = (32 * ks + 8 * fq) * RET_P + trofs;
        const bf16x8 af = tr_frag(Vimg + rb + 32 * w, Vimg + rb + 4 * RET_P + 32 * w);
#pragma unroll
        for (int dt = 0; dt < 8; ++dt) { const bf16x8 bfr = tr_frag(Kimg + rb + 32 * dt, Kimg + rb + 4 * RET_P + 32 * dt); acc[dt] = MFMA16(af, bfr, acc[dt]); }
    }
    float* o = kv + (size_t)unit * 16384;
#pragma unroll
    for (int dt = 0; dt < 8; ++dt)
#pragma unroll
        for (int r = 0; r < 4; ++r) o[(16 * w + 4 * fq + r) * 128 + 16 * dt + fr] = acc[dt][r];
    __syncthreads();
}
__device__ __forceinline__ void scan_phase(const float* kv, bf16* prev, int tid, int vb) {
    for (int i = vb * 512 + tid; i < 32 * 4096; i += gridDim.x * 512) {
        const int chain = i >> 12, e4 = i & 4095, b = chain >> 2, h = chain & 3;
        const float dec = __expf(128.0f * ret_log_gamma(h));
        f32x4 st = (f32x4){0.f, 0.f, 0.f, 0.f}, kq[15];
#pragma unroll
        for (int n = 0; n < 15; ++n) kq[n] = *(const f32x4*)(kv + (size_t)((b * 16 + n) * 4 + h) * 16384 + 4 * e4);
        __builtin_amdgcn_sched_barrier(0);
#pragma unroll
        for (int n = 0; n < 16; ++n) {
            const size_t off = (size_t)((b * 16 + n) * 4 + h) * 16384 + 4 * e4;
            u32x2 w; w.x = pk2(st[0], st[1]); w.y = pk2(st[2], st[3]); *(u32x2*)(prev + off) = w;
            if (n < 15) st = st * dec + kq[n];
        }
    }
}
__device__ __forceinline__ void r2_unit(LAS unsigned char* lds, const bf16* proj, const bf16* prev, bf16* mix, const float* rc, const float* rsn, const float* gnw, int unit, int tid) {
    const int h = unit & 3, n = (unit >> 2) & 15, b = unit >> 6, t0 = b * SEQ + n * 128;
    LAS unsigned char* Kimg = lds; LAS unsigned char* Vimg = lds + 128 * RET_P;
    const float lg = ret_log_gamma(h);
    const int w = tid >> 6, lane = tid & 63, fr = lane & 15, fq = lane >> 4;
    const int qi = 16 * w + fr, tok = t0 + qi, pos = n * 128 + qi;
    const int trofs = (fr >> 2) * RET_P + 8 * (fr & 3);
    u32x4 qlo[2], qhi[2]; f32x4 qc[2][2], qs[2][2];
    {
        const bf16* qp = proj + (size_t)tok * DIN + 768 + h * 128 + 8 * fq;
#pragma unroll
        for (int ks = 0; ks < 2; ++ks) {
            qlo[ks] = *(const u32x4*)(qp + 32 * ks); qhi[ks] = *(const u32x4*)(qp + 32 * ks + 64);
            const float* cp = rc + pos * 64 + 32 * ks + 8 * fq; const float* sp = rsn + pos * 64 + 32 * ks + 8 * fq;
            qc[ks][0] = *(const f32x4*)cp; qc[ks][1] = *(const f32x4*)(cp + 4); qs[ks][0] = *(const f32x4*)sp; qs[ks][1] = *(const f32x4*)(sp + 4);
        }
    }
    u32x4 pv[4];
    if (n > 0) {
        const bf16* pp = prev + (size_t)unit * 16384;
#pragma unroll
        for (int i = 0; i < 4; ++i) { const int idx = tid + 512 * i; pv[i] = *(const u32x4*)(pp + (idx >> 4) * 128 + 8 * (idx & 15)); }
    }
    __builtin_amdgcn_sched_barrier(0);
    ret_load_kv<false>(Kimg, Vimg, proj, rc, rsn, t0, n, h, lg, tid);
    LAS unsigned char* Pimg = lds + 2 * 128 * RET_P;
    if (n > 0) {
#pragma unroll
        for (int i = 0; i < 4; ++i) { const int idx = tid + 512 * i; *(LAS u32x4*)(Pimg + (idx >> 4) * 272 + 16 * (idx & 15)) = pv[i]; }
    }
    __syncthreads();
    bf16x8 q[4];
    const float gq = __expf((float)qi * lg);
#pragma unroll
    for (int ks = 0; ks < 2; ++ks) {
        float r1[8], r2[8];
#pragma unroll
        for (int e = 0; e < 8; ++e) {
            const float x1 = (e & 1) ? bfhi(qlo[ks][e >> 1]) : bflo(qlo[ks][e >> 1]), x2 = (e & 1) ? bfhi(qhi[ks][e >> 1]) : bflo(qhi[ks][e >> 1]);
            const float c = qc[ks][e >> 2][e & 3], sn = qs[ks][e >> 2][e & 3];
            r1[e] = (x1 * c - x2 * sn) * gq; r2[e] = (x1 * sn + x2 * c) * gq;
        }
        u32x4 w1, w2; w1.x = pk2(r1[0], r1[1]); w1.y = pk2(r1[2], r1[3]); w1.z = pk2(r1[4], r1[5]); w1.w = pk2(r1[6], r1[7]);
        w2.x = pk2(r2[0], r2[1]); w2.y = pk2(r2[2], r2[3]); w2.z = pk2(r2[4], r2[5]); w2.w = pk2(r2[6], r2[7]);
        q[ks] = __builtin_bit_cast(bf16x8, w1); q[ks + 2] = __builtin_bit_cast(bf16x8, w2);
    }
    f32x4 y[8];
#pragma unroll
    for (int vt = 0; vt < 8; ++vt) y[vt] = (f32x4){0.f, 0.f, 0.f, 0.f};
    if (n > 0) {
#pragma unroll
        for (int ks = 0; ks < 4; ++ks)
#pragma unroll
            for (int vt = 0; vt < 8; ++vt) { const bf16x8 af = *(const LAS bf16x8*)(Pimg + (16 * vt + fr) * 272 + 64 * ks + 16 * fq); y[vt] = MFMA16(af, q[ks], y[vt]); }
        const float gam = __expf(lg);
#pragma unroll
        for (int vt = 0; vt < 8; ++vt) y[vt] = y[vt] * gam;
    }
    f32x4 s[8];
#pragma unroll
    for (int jt = 0; jt < 8; ++jt) {
        s[jt] = (f32x4){0.f, 0.f, 0.f, 0.f};
        if (jt <= w) {
#pragma unroll
            for (int ks = 0; ks < 4; ++ks) { const bf16x8 af = *(const LAS bf16x8*)(Kimg + (16 * jt + fr) * RET_P + 64 * ks + 16 * fq); s[jt] = MFMA16(af, q[ks], s[jt]); }
            if (jt == w) {
#pragma unroll
                for (int r = 0; r < 4; ++r) { const int j = 16 * jt + 4 * fq + r; s[jt][r] = (qi >= j) ? s[jt][r] : 0.f; }
            }
        }
    }
#pragma unroll
    for (int p = 0; p < 4; ++p) {
        if (2 * p <= w) {
            u32x4 pw; pw.x = pk2(s[2 * p][0], s[2 * p][1]); pw.y = pk2(s[2 * p][2], s[2 * p][3]); pw.z = pk2(s[2 * p + 1][0], s[2 * p + 1][1]); pw.w = pk2(s[2 * p + 1][2], s[2 * p + 1][3]);
            const bf16x8 pb = __builtin_bit_cast(bf16x8, pw);
#pragma unroll
            for (int vt = 0; vt < 8; ++vt) {
                const LAS unsigned char* vp = Vimg + (32 * p + 4 * fq) * RET_P + 32 * vt + trofs;
                y[vt] = MFMA16(tr_frag(vp, vp + 16 * RET_P), pb, y[vt]);
            }
        }
    }
    float sm = 0.f;
#pragma unroll
    for (int vt = 0; vt < 8; ++vt) sm += (y[vt][0] + y[vt][1]) + (y[vt][2] + y[vt][3]);
    sm += __shfl_xor(sm, 16); sm += __shfl_xor(sm, 32);
    const float mu = sm * (1.0f / 128.0f);
    float sq = 0.f;
#pragma unroll
    for (int vt = 0; vt < 8; ++vt) { y[vt] = y[vt] - mu; sq += (y[vt][0] * y[vt][0] + y[vt][1] * y[vt][1]) + (y[vt][2] * y[vt][2] + y[vt][3] * y[vt][3]); }
    sq += __shfl_xor(sq, 16); sq += __shfl_xor(sq, 32);
    const float rstd = 1.0f / sqrtf(sq * (1.0f / 128.0f) + 1e-5f);
    const bf16* gp = proj + (size_t)tok * DIN + 2304 + h * 128 + 4 * fq;
    bf16* op = mix + (size_t)tok * DM + 512 + h * 128 + 4 * fq;
    const float* gw = gnw + h * 128 + 4 * fq;
    u32x2 gva[8]; f32x4 wva[8];
#pragma unroll
    for (int vt = 0; vt < 8; ++vt) { gva[vt] = *(const u32x2*)(gp + 16 * vt); wva[vt] = *(const f32x4*)(gw + 16 * vt); }
    __builtin_amdgcn_sched_barrier(0);
#pragma unroll
    for (int vt = 0; vt < 8; ++vt) {
        const u32x2 gv = gva[vt]; const f32x4 wv = wva[vt];
        const float g0 = bflo(gv.x), g1 = bfhi(gv.x), g2 = bflo(gv.y), g3 = bfhi(gv.y);
        const float o0 = g0 * (y[vt][0] * rstd * wv[0]), o1 = g1 * (y[vt][1] * rstd * wv[1]);
        const float o2 = g2 * (y[vt][2] * rstd * wv[2]), o3 = g3 * (y[vt][3] * rstd * wv[3]);
        u32x2 w2; w2.x = pk2(o0, o1); w2.y = pk2(o2, o3); *(u32x2*)((unsigned char*)mix + pg8::a_tiled_off(tok, 512 + h * 128 + 16 * vt + 4 * fq, DM)) = w2;
    }
    __syncthreads();
}

__device__ __forceinline__ void final_phase(float* out, const bf16* hb, const float* part, const float* wf, int tid, int vb) {
    const int lane = tid & 63, G = gridDim.x;
    const int m_lo = (G == 256) ? vb * 64 + (tid >> 6) : vb * NWAVES + (tid >> 6), m_hi = (G == 256) ? vb * 64 + 64 : M, m_st = (G == 256) ? NWAVES : G * NWAVES;
    for (int m = m_lo; m < m_hi; m += m_st) {
        float s = lane < 16 ? part[(size_t)m * 16 + lane] : 0.f;
        s = wave_sum(s);
        const float rs = 1.0f / sqrtf(s * (1.0f / 1024.0f) + 1e-6f);
        const u32x2* hr = (const u32x2*)(hb + (size_t)m * DM) + lane; f32x4* xr = (f32x4*)(out + (size_t)m * DM) + lane; const f32x4* wr = (const f32x4*)wf + lane;
#pragma unroll
        for (int j = 0; j < 4; ++j) { const u32x2 hv = *(const u32x2*)((const unsigned char*)hb + pg8::a_tiled_off(m, 4 * (lane + 64 * j), DM)); const f32x4 v = (f32x4){bflo(hv.x), bfhi(hv.x), bflo(hv.y), bfhi(hv.y)}; xr[64 * j] = v * rs * wr[64 * j]; }
    }
}

constexpr int RTAB_OFF = 131072;
__device__ __forceinline__ void rstd_table(LAS unsigned char* lds, const float* part, int pm, int tid, int slot) {
    if (pm >= 0) {
        const int r = tid >> 1, hs = tid & 1;
        const float* pp = part + (size_t)(pm * 256 + r) * 16 + 8 * hs;
        const f32x4 a = *(const f32x4*)pp, b = *(const f32x4*)(pp + 4);
        float sm = ((a[0] + a[1]) + (a[2] + a[3])) + ((b[0] + b[1]) + (b[2] + b[3]));
        sm += __shfl_xor(sm, 1);
        if (hs == 0) ((LAS float*)(lds + RTAB_OFF))[slot + r] = 1.0f / sqrtf(sm * (1.0f / 1024.0f) + 1e-6f);
    }
    __syncthreads();
}

__global__ void __launch_bounds__(NWAVES * 64, 2) fwd_kernel(Args a) {
    extern __shared__ __attribute__((aligned(16))) unsigned char lds_raw[];
    LAS unsigned char* lds = (LAS unsigned char*)lds_raw;
    const int G = gridDim.x;
#define BAR_CTL ((unsigned*)(a.ws + WS_CTL))
#define BAR_ST ((volatile LAS unsigned*)(lds + LDS_BARST))
#define BAR_X (a.use_sync ? xb_xcc_id() : 0u)
    if (a.use_sync) {
        if (threadIdx.x < 16) ((LAS unsigned*)(lds + LDS_BARST))[threadIdx.x] = 0u;
        __syncthreads();
        if (threadIdx.x == 0) BAR_ST[2] = xb_add(&BAR_CTL[XB_XCNT(xb_xcc_id())], 1u);
    }
#pragma nounroll
    for (int ph = a.ph_lo; ph < a.ph_hi; ++ph) {
        const int sidx = (ph == 0) ? 9 : ((ph == NPH - 1) ? 10 : (ph - 1) % 9);
        const int nrep = ((PROBE_REP_MASK >> sidx) & 1) ? 2 : 1;
#pragma nounroll
        for (int rep = 0; rep < nrep; ++rep) {
        int tid = threadIdx.x; asm volatile("" : "+v"(tid));
        const unsigned xmode = a.use_sync ? BAR_ST[3] : 0u, xrank = a.use_sync ? BAR_ST[2] : 0u;
        const int vcu = xmode ? (int)(xrank * 8u + BAR_X) : (int)blockIdx.x;
        const int vb = xmode ? (int)(BAR_X * 32u + xrank) : (int)blockIdx.x;
        size_t wsz = 0; asm volatile("" : "+s"(wsz)); unsigned char* ws = a.ws + wsz;
        bf16* hb = (bf16*)(ws + WS_HB); bf16* act = (bf16*)(ws + WS_ACT); bf16* mix = (bf16*)(ws + WS_MIX);
        float* part = (float*)(ws + WS_PART); float* kv = (float*)(ws + WS_KV); bf16* prev = (bf16*)(ws + WS_PREV);
        const float* rc = (const float*)(ws + WS_ROPE); const float* rsn = rc + SEQ * 64;
        if (ph == 0) prologue(a, lds, tid);
        else if (ph == NPH - 1) final_phase(a.out, hb, part, a.in[14], tid, vb);
        else {
            const int l = (ph - 1) / 9, s = (ph - 1) % 9;
            const bf16* wl = (const bf16*)(ws + WS_W) + (size_t)l * L_STRIDE;
            if (s == 0 || s == 7) {
                pg8::Gemm g{hb, wl + (s == 0 ? O_GU1 : O_GU2), M, 2 * FF, DM}; pg8::StaticOrder S; S.init(M, 2 * FF, G, vcu);
                pg8::Unit u0, uh; u0.pm = -1; uh.pm = -1; (void)S.next(0, u0); (void)S.next(S.nwg / S.G, uh);
                rstd_table(lds, part, u0.pm, tid, 0); rstd_table(lds, part, uh.pm, tid, 256);
                pg8::EpiSwiGLU E{act, FF, part, (const LAS float*)(lds + RTAB_OFF), u0.pm, uh.pm};
                pg8::gemm_phase<pg8::EpiSwiGLU, pg8::StaticOrder, true, true>(lds, g, S, E);
            } else if (s == 1 || s == 8 || s == 6) {
                const bool isout = (s == 6);
                pg8::Gemm g{isout ? mix : act, wl + (s == 1 ? O_D1 : (s == 8 ? O_D2 : O_OUT)), M, DM, isout ? DM : FF}; pg8::StaticOrder S; S.init(M, DM, G, vcu);
                pg8::EpiResid E{hb, part, (rep + 1 < nrep) ? 0.0f : (isout ? 1.0f : 0.5f)};
                pg8::gemm_phase<pg8::EpiResid, pg8::StaticOrder, true, true>(lds, g, S, E);
            } else if (s == 2) {
                pg8::Gemm g{hb, wl + O_IN, M, DIN, DM}; pg8::StaticOrder S; S.init(M, DIN, G, vcu);
                pg8::Unit u0; u0.pm = -1; (void)S.next(0, u0);
                rstd_table(lds, part, u0.pm, tid, 0);
                pg8::EpiScaleBf16 E{act, DIN, part, 9, (const LAS float*)(lds + RTAB_OFF), u0.pm};
                pg8::gemm_phase<pg8::EpiScaleBf16, pg8::StaticOrder, true, true>(lds, g, S, E);
            } else if (s == 3) {
                for (int u = vb; u < 256; u += G) att_unit(lds, act, mix, a.in[7] + l * 8, u, tid);
                if (G == 256) { for (int k = 0; k < 2; ++k) r1_unit(lds, act, kv, rc, rsn, (vb >> 5) * 64 + (vb & 31) + 32 * k, tid); }
                else for (int u = vb; u < 512; u += G) r1_unit(lds, act, kv, rc, rsn, u, tid);
            } else if (s == 4) {
                scan_phase(kv, prev, tid, vb);
            } else {
                if (G == 256) { for (int k = 0; k < 2; ++k) r2_unit(lds, act, prev, mix, rc, rsn, a.in[8] + l * 512, (vb >> 5) * 64 + (vb & 31) + 32 * k, tid); }
                else for (int u = vb; u < 512; u += G) r2_unit(lds, act, prev, mix, rc, rsn, a.in[8] + l * 512, u, tid);
            }
        }
        }
        if (ph + 1 < a.ph_hi && a.use_sync) {
            if (ph == 0) {
                if (G != 256) cg::this_grid().sync();
                else { XcdBarrier bar; bar.bar = BAR_CTL; bar.x = xb_xcc_id(); bar.st = BAR_ST; xcd_barrier(bar); }
                if (threadIdx.x == 0) {
                    unsigned nloc = 0u, nx = 0u, ok = (G == 256) ? 1u : 0u;
                    const unsigned myx = xb_xcc_id();
                    for (unsigned j = 0; j < 16; ++j) { const unsigned c = xb_ld(&BAR_CTL[XB_XCNT(j)]); nx += c ? 1u : 0u; if (j == myx) nloc = c; if (c != (j < 8u ? 32u : 0u)) ok = 0u; }
                    BAR_ST[0] = nloc ? nloc : 1u; BAR_ST[1] = nx ? nx : 1u; BAR_ST[3] = ok;
                }
                __syncthreads();
            } else if (BAR_ST[3]) xcd_local_barrier(BAR_CTL, xb_xcc_id(), BAR_ST[0]);
            else { XcdBarrier bar; bar.bar = BAR_CTL; bar.x = xb_xcc_id(); bar.st = BAR_ST; xcd_barrier(bar); }
        }
    }
}

extern "C" void kernel_launch(void* const* d_in, const int* in_sizes, int n_in, void* d_out, int out_size, void* d_ws, size_t ws_size, hipStream_t stream) {
    static int grid = 0;
    if (grid == 0) {
        if (n_in != 15 || out_size != M * DM || ws_size < WS_END) { fprintf(stderr, "kernel_launch: unexpected shapes (n_in %d out %d ws %zu)\n", n_in, out_size, ws_size); grid = -1; return; }
        if (hipFuncSetAttribute((const void*)fwd_kernel, hipFuncAttributeMaxDynamicSharedMemorySize, LDS_BYTES) != hipSuccess) { fprintf(stderr, "kernel_launch: hipFuncSetAttribute failed\n"); grid = -1; return; }
        int dev = 0, cus = 0, per_cu = 0;
        hipGetDevice(&dev); hipDeviceGetAttribute(&cus, hipDeviceAttributeMultiprocessorCount, dev);
        hipOccupancyMaxActiveBlocksPerMultiprocessor(&per_cu, (const void*)fwd_kernel, NWAVES * 64, LDS_BYTES);
        (void)hipGetLastError();
        if (per_cu < 1) per_cu = 1;
        grid = cus > 0 ? cus : 256;
    }
    if (grid < 0) return;
    if (hipMemsetAsync((char*)d_ws + WS_CTL, 0, CTL_ZERO_BYTES, stream) != hipSuccess) { fprintf(stderr, "kernel_launch: memset failed\n"); return; }
    Args a{};
    for (int i = 0; i < 15; ++i) a.in[i] = (const float*)d_in[i];
    a.out = (float*)d_out; a.ws = (unsigned char*)d_ws;
#if MK_MULTI
    for (int ph = 0; ph < NPH; ++ph) { a.ph_lo = ph; a.ph_hi = ph + 1; a.use_sync = 0; hipLaunchKernelGGL(fwd_kernel, dim3(grid), dim3(NWAVES * 64), LDS_BYTES, stream, a); }
#else
    a.ph_lo = 0; a.ph_hi = NPH; a.use_sync = 1;
    void* args[] = {&a};
    hipError_t e = hipLaunchCooperativeKernel((const void*)fwd_kernel, dim3(grid), dim3(NWAVES * 64), args, LDS_BYTES, stream);
    if (e != hipSuccess) fprintf(stderr, "cooperative launch failed: %s (grid %d)\n", hipGetErrorString(e), grid);
#endif
}
```

```cpp
#include <hip/hip_runtime.h>
#include <hip/hip_cooperative_groups.h>
#include <cstdio>
#include <cstdint>
namespace cg = cooperative_groups;
#ifndef MK_MULTI
#define MK_MULTI 0
#endif
#ifndef PROBE_REP_MASK
#define PROBE_REP_MASK 0
#endif
namespace pg8 {
#define PG8_LAS __attribute__((address_space(3)))
typedef unsigned short bf16_t;
typedef short bf16x8 __attribute__((ext_vector_type(8)));
typedef float f32x4 __attribute__((ext_vector_type(4)));
typedef unsigned u32x4 __attribute__((ext_vector_type(4)));
constexpr int BM = 256, BK = 64, HALF = 128, HTB = HALF * BK * 2  , STAGE_BYTES = 8 * HTB, NXCD = 8, WGM = 8;

__host__ __device__ __forceinline__ int lds_byte(int r, int c) { const int st = (r >> 4) * 2 + (c >> 5), rr = r & 15, cc = c & 31, ob = rr * 64 + cc * 2; return st * 1024 + (ob ^ (((ob >> 9) & 1) << 5)); }
__host__ __device__ __forceinline__ void stage_rc(int b, int& R, int& C) { const int st = b / 1024, sb = b % 1024, swz = sb ^ (((sb >> 9) & 1) << 5); R = (st >> 1) * 16 + swz / 64; C = (st & 1) * 32 + (swz % 64) / 2; }
__host__ __device__ __forceinline__ int perm32(int rho) { const int n = rho >> 4, i = rho & 15; return 8 * (i >> 2) + 4 * n + (i & 3); }

__host__ __device__ __forceinline__ size_t a_tiled_off(int m, int c, int K) { return (size_t)(m >> 8) * 256 * K * 2 + (size_t)((c >> 6) * 2 + ((m >> 7) & 1)) * 16384 + (size_t)lds_byte(m & 127, c & 63); }
struct Unit { int pm, pn, hf; };
struct Gemm { const bf16_t* A; const bf16_t* Bt; int M, N, K; };

struct StaticOrder {
    int nM, nN, nwg, G, c;
    __host__ __device__ void init(int M, int N, int G_, int c_) { nM = M / BM; nN = N / BM; nwg = nM * nN; G = G_; c = c_; }
    __host__ __device__ bool next(int i, Unit& u) const {
        long L = (long)i * G + c; u.hf = 0;
        const int nfull = nwg / G;
        if ((G % 16 == 0) && (nwg % G == G / 2) && i >= nfull) { if (i > nfull) return false; L = (long)nfull * G + ((c >> 4) << 3) + (c & 7); u.hf = 1 + ((c >> 3) & 1); }
        else if (L >= nwg) return false;
        int wgid = (int)L; { const int q = nwg / NXCD, r = nwg % NXCD, xcd = wgid % NXCD, off = wgid / NXCD; wgid = (xcd < r ? xcd * (q + 1) : r * (q + 1) + (xcd - r) * q) + off; }
        const int nig = WGM * nN, gid = wgid / nig, fm = gid * WGM, gsz = (nM - fm) < WGM ? (nM - fm) : WGM;
        u.pm = fm + ((wgid % nig) % gsz); u.pn = (wgid % nig) / gsz; return true;
    }
    __device__ __forceinline__ void a_ready(const Unit&) const {}
    __device__ __forceinline__ void done(const Unit&) const {}
};

__device__ __forceinline__ unsigned cvt_pk_bf16(float lo, float hi) { unsigned r; asm volatile("v_cvt_pk_bf16_f32 %0, %1, %2" : "=v"(r) : "v"(lo), "v"(hi)); return r; }
typedef float f32x2 __attribute__((ext_vector_type(2)));
typedef unsigned u32x2 __attribute__((ext_vector_type(2)));
constexpr int PART_N = 16;
__device__ __forceinline__ float row_rstd(const float* part, int row, int fq) {
    const f32x4 p = *(const f32x4*)(part + (size_t)row * PART_N + 4 * fq);
    float s = (p[0] + p[1]) + (p[2] + p[3]);
    s += __shfl_xor(s, 16); s += __shfl_xor(s, 32);
    return 1.0f / sqrtf(s * (1.0f / 1024.0f) + 1e-6f);
}
__device__ __forceinline__ float silu_f(float g) { return g * __builtin_amdgcn_rcpf(1.0f + __builtin_amdgcn_exp2f(-1.44269504f * g)); }
struct EpiSwiGLU {
    static constexpr bool PERM = true, AFTER_DRAIN = false;
    bf16_t* O; int ldo; const float* part; const PG8_LAS float* rtab; int rpm, rpm2;
    __device__ __forceinline__ void operator()(const f32x4 (&acc)[2][2][4][2], const Unit& u, int wr, int wc, int fr, int fq) const {
        const int row0 = u.pm * BM + (u.hf == 2 ? HALF : 0) + wr * 64 + fr, col0 = u.pn * HALF + wc * 32 + 8 * fq;
        float rsv[2][4];
        if (u.pm == rpm || u.pm == rpm2) {
            const PG8_LAS float* rt = rtab + (u.pm == rpm ? 0 : 256);
#pragma unroll
            for (int ai = 0; ai < 2; ++ai)
#pragma unroll
                for (int m = 0; m < 4; ++m) rsv[ai][m] = rt[(row0 - u.pm * BM + ai * HALF + m * 16) & 255];
        } else {
#pragma unroll
            for (int ai = 0; ai < 2; ++ai)
#pragma unroll
                for (int m = 0; m < 4; ++m) rsv[ai][m] = row_rstd(part, row0 + ai * HALF + m * 16, fq);
        }
#pragma unroll
        for (int ai = 0; ai < 2; ++ai) {
            if (ai == 1 && u.hf) break;
#pragma unroll
            for (int m = 0; m < 4; ++m) {
                const int row = row0 + ai * HALF + m * 16; const float rs = rsv[ai][m];
                const float rsc = rs * -1.44269504f, rs2 = rs * rs;
                unsigned wv[4];
#pragma unroll
                for (int n = 0; n < 2; ++n)
#pragma unroll
                    for (int e = 0; e < 2; ++e) {
                        const f32x2 g2 = {acc[ai][0][m][n][2 * e], acc[ai][0][m][n][2 * e + 1]}, u2 = {acc[ai][1][m][n][2 * e], acc[ai][1][m][n][2 * e + 1]};
                        const f32x2 t = g2 * rsc;
                        f32x2 d; d.x = __builtin_amdgcn_exp2f(t.x); d.y = __builtin_amdgcn_exp2f(t.y);
                        d = d + 1.0f;
                        f32x2 r; r.x = __builtin_amdgcn_rcpf(d.x); r.y = __builtin_amdgcn_rcpf(d.y);
                        const f32x2 o = ((g2 * u2) * r) * rs2;
                        wv[2 * n + e] = cvt_pk_bf16(o.x, o.y);
                    }
                u32x4 w; w.x = wv[0]; w.y = wv[1]; w.z = wv[2]; w.w = wv[3];
                *(u32x4*)((unsigned char*)O + a_tiled_off(row, col0, ldo)) = w;
            }
        }
    }
};
struct EpiScaleBf16 {
    static constexpr bool PERM = true, AFTER_DRAIN = false;
    bf16_t* O; int ldo; const float* part; int gate_pn; const PG8_LAS float* rtab; int rpm;
    __device__ __forceinline__ void operator()(const f32x4 (&acc)[2][2][4][2], const Unit& u, int wr, int wc, int fr, int fq) const {
        const int row0 = u.pm * BM + wr * 64 + fr, col0 = u.pn * BM + wc * 32 + 8 * fq;
        const bool gate = u.pn >= gate_pn;
        float rsv[2][4];
        if (u.pm == rpm) {
#pragma unroll
            for (int ai = 0; ai < 2; ++ai)
#pragma unroll
                for (int m = 0; m < 4; ++m) rsv[ai][m] = rtab[(row0 - u.pm * BM + ai * HALF + m * 16) & 255];
        } else {
#pragma unroll
            for (int ai = 0; ai < 2; ++ai)
#pragma unroll
                for (int m = 0; m < 4; ++m) rsv[ai][m] = row_rstd(part, row0 + ai * HALF + m * 16, fq);
        }
#pragma unroll
        for (int ai = 0; ai < 2; ++ai)
#pragma unroll
            for (int m = 0; m < 4; ++m) {
                const int row = row0 + ai * HALF + m * 16; const float rs = rsv[ai][m];
#pragma unroll
                for (int bj = 0; bj < 2; ++bj) {
                    f32x4 v0 = acc[ai][bj][m][0] * rs, v1 = acc[ai][bj][m][1] * rs;
                    if (gate) {
                        f32x4 d0 = v0 * -1.44269504f, d1 = v1 * -1.44269504f;
#pragma unroll
                        for (int e = 0; e < 4; ++e) { d0[e] = __builtin_amdgcn_exp2f(d0[e]); d1[e] = __builtin_amdgcn_exp2f(d1[e]); }
                        d0 = d0 + 1.0f; d1 = d1 + 1.0f;
#pragma unroll
                        for (int e = 0; e < 4; ++e) { d0[e] = __builtin_amdgcn_rcpf(d0[e]); d1[e] = __builtin_amdgcn_rcpf(d1[e]); }
                        v0 = v0 * d0; v1 = v1 * d1;
                    }
                    u32x4 w; w.x = cvt_pk_bf16(v0[0], v0[1]); w.y = cvt_pk_bf16(v0[2], v0[3]); w.z = cvt_pk_bf16(v1[0], v1[1]); w.w = cvt_pk_bf16(v1[2], v1[3]);
                    *(u32x4*)(O + (size_t)row * ldo + col0 + bj * HALF) = w;
                }
            }
    }
};
struct EpiResid {
    static constexpr bool PERM = true, AFTER_DRAIN = false;
    bf16_t* hb; float* part; float scale;
    __device__ __forceinline__ void operator()(const f32x4 (&acc)[2][2][4][2], const Unit& u, int wr, int wc, int fr, int fq) const {
        const int row0 = u.pm * BM + wr * 64 + fr, col0 = u.pn * BM + wc * 32 + 8 * fq;
#pragma unroll
        for (int am = 0; am < 4; ++am) {
            const int ai = am >> 1;
            u32x4 bw[4][2];
#pragma unroll
            for (int m = 2 * (am & 1); m < 2 * (am & 1) + 2; ++m)
#pragma unroll
                for (int bj = 0; bj < 2; ++bj) bw[m][bj] = *(const u32x4*)((const unsigned char*)hb + a_tiled_off(row0 + ai * HALF + m * 16, col0 + bj * HALF, 1024));
#pragma unroll
            for (int m = 2 * (am & 1); m < 2 * (am & 1) + 2; ++m) {
                const int row = row0 + ai * HALF + m * 16; float ss = 0.f;
#pragma unroll
                for (int bj = 0; bj < 2; ++bj) {
                    const size_t off = (size_t)row * 1024 + col0 + bj * HALF;
                    const u32x4 b = bw[m][bj];
                    const f32x4 b0 = (f32x4){__uint_as_float(b.x << 16), __uint_as_float(b.x & 0xffff0000u), __uint_as_float(b.y << 16), __uint_as_float(b.y & 0xffff0000u)};
                    const f32x4 b1 = (f32x4){__uint_as_float(b.z << 16), __uint_as_float(b.z & 0xffff0000u), __uint_as_float(b.w << 16), __uint_as_float(b.w & 0xffff0000u)};
                    const f32x4 h0 = b0 + acc[ai][bj][m][0] * scale, h1 = b1 + acc[ai][bj][m][1] * scale;
                    u32x4 w; w.x = cvt_pk_bf16(h0[0], h0[1]); w.y = cvt_pk_bf16(h0[2], h0[3]); w.z = cvt_pk_bf16(h1[0], h1[1]); w.w = cvt_pk_bf16(h1[2], h1[3]);
                    *(u32x4*)((unsigned char*)hb + a_tiled_off(row, col0 + bj * HALF, 1024)) = w;
                    ss += (h0[0] * h0[0] + h0[1] * h0[1]) + (h0[2] * h0[2] + h0[3] * h0[3]) + (h1[0] * h1[0] + h1[1] * h1[1]) + (h1[2] * h1[2] + h1[3] * h1[3]);
                }
                ss += __shfl_xor(ss, 16); ss += __shfl_xor(ss, 32);
                if (fq == 0) part[(size_t)row * PART_N + u.pn * 4 + wc] = ss;
            }
            asm volatile("" ::: "memory");
        }
    }
};
template <class Epi, class Sched, bool ALIGN_EPI = false, bool SP2 = false>
__device__ __forceinline__ void gemm_phase(PG8_LAS unsigned char* lds, const Gemm g, const Sched& S, const Epi& E) {
    int tid_ = threadIdx.x; asm volatile("" : "+v"(tid_)); const int tid = tid_, wid = __builtin_amdgcn_readfirstlane(tid >> 6), lane = tid & 63, wr = wid >> 2, wc = wid & 3, fr = lane & 15, fq = lane >> 4;
    const int K = g.K, nt = K / BK;
    unsigned voffA[2], voffB[2];
#pragma unroll
    for (int i = 0; i < 2; ++i) { int R, C; stage_rc(tid * 16 + i * 8192, R, C); const int Rb = Epi::PERM ? ((R & ~31) + perm32(R & 31)) : R;
        voffA[i] = (unsigned)(tid * 16 + i * 8192); voffB[i] = voffA[i]; (void)Rb; (void)R; (void)C; }
    const size_t kstep = 32768;
    const size_t hstep = 16384;
    const size_t tstep = (size_t)256 * K * 2;
    const size_t kstepB = 32768, hstepB = 16384;
    const unsigned ldsw = (unsigned)wid * 1024u;
    const int aoff = lds_byte(wr * 64 + fr, fq * 8), boff = lds_byte(wc * 32 + fr, fq * 8);
#define PG8_SA(b, h) (((b) * 2 + (h)) * HTB)
#define PG8_SB(b, h) ((4 + (b) * 2 + (h)) * HTB)
#define PG8_STAGE(bufoff, gbase, voff) do { _Pragma("unroll") for (int _i = 0; _i < 2; ++_i) \
        __builtin_amdgcn_global_load_lds((const unsigned*)((const char*)(gbase) + (voff)[_i]), (PG8_LAS unsigned*)(lds + (bufoff) + ldsw + _i * 8192), 16, 0, 0); } while (0)
#define PG8_LDA(dst, b, h) do { _Pragma("unroll") for (int m = 0; m < 4; ++m) _Pragma("unroll") for (int k = 0; k < 2; ++k) dst[m][k] = *(const PG8_LAS bf16x8*)(lds + PG8_SA(b, h) + aoff + m * 2048 + k * 1024); } while (0)
#define PG8_LDB(dst, b, h) do { _Pragma("unroll") for (int n = 0; n < 2; ++n) _Pragma("unroll") for (int k = 0; k < 2; ++k) dst[n][k] = *(const PG8_LAS bf16x8*)(lds + PG8_SB(b, h) + boff + n * 2048 + k * 1024); } while (0)
#define PG8_MMA(ai, bj, At, Bt) do { __builtin_amdgcn_s_setprio(1); _Pragma("unroll") for (int m = 0; m < 4; ++m) _Pragma("unroll") for (int n = 0; n < 2; ++n) _Pragma("unroll") for (int k = 0; k < 2; ++k) \
        acc[ai][bj][m][n] = __builtin_amdgcn_mfma_f32_16x16x32_bf16(Bt[n][k], At[m][k], acc[ai][bj][m][n], 0, 0, 0); __builtin_amdgcn_s_setprio(0); } while (0)
#define PG8_WAIT_V(n) asm volatile("s_waitcnt vmcnt(" #n ")" ::: "memory")
#define PG8_WAIT_L(n) asm volatile("s_waitcnt lgkmcnt(" #n ")" ::: "memory")
#define PG8_BAR __builtin_amdgcn_s_barrier()
#define PG8_SCHED __builtin_amdgcn_sched_barrier(0)
    Unit cur, nxt; int ui = 0;
    if (!S.next(0, cur)) return;
    f32x4 acc[2][2][4][2];
#pragma unroll
    for (int a = 0; a < 2; ++a)
#pragma unroll
        for (int b = 0; b < 2; ++b)
#pragma unroll
            for (int m = 0; m < 4; ++m)
#pragma unroll
                for (int n = 0; n < 2; ++n) acc[a][b][m][n] = (f32x4){0.f, 0.f, 0.f, 0.f};
    bf16x8 At[4][2], B0[2][2], B1[2][2];
    const char* cA = (const char*)g.A + (size_t)cur.pm * tstep + (cur.hf == 2 ? hstep : (size_t)0); const char* cB = (const char*)g.Bt + (size_t)cur.pn * tstep;
    S.a_ready(cur);
    if constexpr (SP2) {
        PG8_STAGE(PG8_SB(0, 0), cB, voffB); PG8_STAGE(PG8_SB(0, 1), cB + hstepB, voffB); PG8_STAGE(PG8_SA(0, 0), cA, voffA); PG8_STAGE(PG8_SA(0, 1), cA + hstep, voffA);
        if (wr == 1) PG8_BAR;
        PG8_WAIT_V(2); PG8_BAR;
        PG8_STAGE(PG8_SB(1, 0), cB + kstepB, voffB); PG8_STAGE(PG8_SA(1, 0), cA + kstep, voffA); PG8_STAGE(PG8_SB(1, 1), cB + hstepB + kstepB, voffB);
        PG8_WAIT_V(6); PG8_BAR;
    } else {
        PG8_STAGE(PG8_SB(0, 0), cB, voffB); PG8_STAGE(PG8_SA(0, 0), cA, voffA); PG8_STAGE(PG8_SB(0, 1), cB + hstepB, voffB); PG8_STAGE(PG8_SA(0, 1), cA + hstep, voffA);
        if (wr == 1) PG8_BAR;
        PG8_WAIT_V(4); PG8_BAR;
        PG8_STAGE(PG8_SB(1, 0), cB + kstepB, voffB); PG8_STAGE(PG8_SA(1, 0), cA + kstep, voffA); PG8_STAGE(PG8_SB(1, 1), cB + hstepB + kstepB, voffB);
        PG8_WAIT_V(6); PG8_BAR;
    }
    for (;;) {
        const bool has_next = S.next(ui + 1, nxt);
        const char* nA = has_next ? (const char*)g.A + (size_t)nxt.pm * tstep + (nxt.hf == 2 ? hstep : (size_t)0) : cA; const char* nB = has_next ? (const char*)g.Bt + (size_t)nxt.pn * tstep : cB;
        for (int t = 0; t < nt; t += 2) {
            const bool last = (t == nt - 2);
            const char* a1 = cA + (size_t)(t + 1) * kstep;
            const char* a2 = last ? nA : cA + (size_t)(t + 2) * kstep; const char* b2 = last ? nB : cB + (size_t)(t + 2) * kstepB;
            const char* a3 = a2 + kstep; const char* b3 = b2 + kstepB;
            if (last && has_next) S.a_ready(nxt);
            if constexpr (SP2) {
            PG8_LDB(B0, 0, 0); PG8_LDB(B1, 0, 1); PG8_SCHED; PG8_LDA(At, 0, 0); PG8_STAGE(PG8_SA(1, 1), a1 + hstep, voffA);
            PG8_WAIT_V(8); PG8_WAIT_L(0); PG8_BAR; PG8_MMA(0, 0, At, B0); PG8_MMA(0, 1, At, B1); PG8_BAR; PG8_SCHED;
            PG8_LDA(At, 0, 1); PG8_STAGE(PG8_SB(0, 0), b2, voffB); PG8_STAGE(PG8_SB(0, 1), b2 + hstepB, voffB); PG8_STAGE(PG8_SA(0, 0), a2, voffA);
            PG8_WAIT_V(8); PG8_WAIT_L(0); PG8_BAR; if (!cur.hf) { PG8_MMA(1, 0, At, B0); PG8_MMA(1, 1, At, B1); } PG8_BAR; PG8_SCHED;
            PG8_LDB(B0, 1, 0); PG8_LDB(B1, 1, 1); PG8_SCHED; PG8_LDA(At, 1, 0); PG8_STAGE(PG8_SA(0, 1), a2 + hstep, voffA);
            PG8_WAIT_V(8); PG8_WAIT_L(0); PG8_BAR; PG8_MMA(0, 0, At, B0); PG8_MMA(0, 1, At, B1); PG8_BAR; PG8_SCHED;
            PG8_LDA(At, 1, 1); PG8_STAGE(PG8_SB(1, 0), b3, voffB); PG8_STAGE(PG8_SB(1, 1), b3 + hstepB, voffB); PG8_STAGE(PG8_SA(1, 0), a3, voffA);
            PG8_WAIT_V(8); PG8_WAIT_L(0); PG8_BAR; if (!cur.hf) { PG8_MMA(1, 0, At, B0); PG8_MMA(1, 1, At, B1); } PG8_BAR; PG8_SCHED;
            } else {
            PG8_LDB(B0, 0, 0); PG8_SCHED; PG8_LDA(At, 0, 0); PG8_STAGE(PG8_SA(1, 1), a1 + hstep, voffA);
            PG8_WAIT_L(8); PG8_BAR; PG8_WAIT_L(0); PG8_MMA(0, 0, At, B0); PG8_BAR; PG8_SCHED;
            PG8_LDB(B1, 0, 1); PG8_STAGE(PG8_SB(0, 0), b2, voffB);
            PG8_BAR; PG8_WAIT_L(0); PG8_MMA(0, 1, At, B1); PG8_BAR;
            PG8_LDA(At, 0, 1); PG8_STAGE(PG8_SA(0, 0), a2, voffA);
            PG8_BAR; PG8_WAIT_L(0); PG8_MMA(1, 0, At, B0); PG8_BAR; PG8_SCHED;
            PG8_STAGE(PG8_SB(0, 1), b2 + hstepB, voffB);
            PG8_WAIT_V(6); PG8_BAR; PG8_MMA(1, 1, At, B1); PG8_BAR;
            PG8_LDB(B0, 1, 0); PG8_SCHED; PG8_LDA(At, 1, 0); PG8_STAGE(PG8_SA(0, 1), a2 + hstep, voffA);
            PG8_WAIT_L(8); PG8_BAR; PG8_WAIT_L(0); PG8_MMA(0, 0, At, B0); PG8_BAR; PG8_SCHED;
            PG8_LDB(B1, 1, 1); PG8_STAGE(PG8_SB(1, 0), b3, voffB);
            PG8_BAR; PG8_WAIT_L(0); PG8_MMA(0, 1, At, B1); PG8_BAR;
            PG8_LDA(At, 1, 1); PG8_STAGE(PG8_SA(1, 0), a3, voffA);
            PG8_BAR; PG8_WAIT_L(0); PG8_MMA(1, 0, At, B0); PG8_BAR; PG8_SCHED;
            PG8_STAGE(PG8_SB(1, 1), b3 + hstepB, voffB);
            PG8_WAIT_V(6); PG8_BAR; PG8_MMA(1, 1, At, B1); PG8_BAR;
            }
        }
        if constexpr (ALIGN_EPI) { if (wr == 0) PG8_BAR; }
        if constexpr (!Epi::AFTER_DRAIN) { E(acc, cur, wr, wc, fr, fq); S.done(cur); }
        if (!has_next) break;
#pragma unroll
        for (int a = 0; a < 2; ++a)
#pragma unroll
            for (int b = 0; b < 2; ++b)
#pragma unroll
                for (int m = 0; m < 4; ++m)
#pragma unroll
                    for (int n = 0; n < 2; ++n) acc[a][b][m][n] = (f32x4){0.f, 0.f, 0.f, 0.f};
        cur = nxt; cA = nA; cB = nB; ++ui;
        if constexpr (ALIGN_EPI) { if (wr == 1) PG8_BAR; }
    }
    PG8_WAIT_V(0);
    if constexpr (!ALIGN_EPI) { if (wr == 0) PG8_BAR; }
    PG8_BAR;
    if constexpr (Epi::AFTER_DRAIN) { E.fused(acc, cur, wr, wc, fr, fq, lds, wid, lane); S.done(cur); }
#undef PG8_SA
#undef PG8_SB
#undef PG8_STAGE
#undef PG8_LDA
#undef PG8_LDB
#undef PG8_MMA
#undef PG8_WAIT_V
#undef PG8_WAIT_L
#undef PG8_BAR
#undef PG8_SCHED
}
}
constexpr int NWAVES = 8;
constexpr int BATCH = 8, SEQ = 2048, DM = 1024, FF = 2816, DIN = 2816, DEPTH = 4;
constexpr int M = BATCH * SEQ;
constexpr int NPH = 2 + 9 * DEPTH;
constexpr size_t MiB = 1u << 20;
constexpr size_t WS_CTL = 0, CTL_ZERO_BYTES = 32768;
constexpr size_t WS_ROPE = 1 * MiB;
constexpr size_t WS_PART = 2 * MiB;
constexpr size_t WS_W = 4 * MiB;
constexpr size_t E_GU = (size_t)2 * FF * DM, E_DN = (size_t)DM * FF, E_IN = (size_t)DIN * DM, E_OUT = (size_t)DM * DM;
constexpr size_t O_GU1 = 0, O_D1 = E_GU, O_IN = O_D1 + E_DN, O_OUT = O_IN + E_IN, O_GU2 = O_OUT + E_OUT, O_D2 = O_GU2 + E_GU, L_STRIDE = O_D2 + E_DN;
constexpr size_t WS_HB = 166 * MiB;
constexpr size_t WS_ACT = 198 * MiB;
constexpr size_t WS_MIX = 286 * MiB;
constexpr size_t WS_KV = 318 * MiB;
constexpr size_t WS_PREV = 350 * MiB;
constexpr size_t WS_END = 366 * MiB;
static_assert(WS_W + DEPTH * L_STRIDE * 2 <= WS_HB, "weights fit");
constexpr int LDS_BYTES = 147456, LDS_BARST = LDS_BYTES - 64;

#define LAS __attribute__((address_space(3)))
typedef unsigned short bf16;
typedef float f32x4 __attribute__((ext_vector_type(4)));
typedef short bf16x8 __attribute__((ext_vector_type(8)));
typedef short s16x4 __attribute__((ext_vector_type(4)));
typedef unsigned u32x4 __attribute__((ext_vector_type(4)));
typedef unsigned u32x2 __attribute__((ext_vector_type(2)));
#define LDS_WAIT() asm volatile("s_waitcnt lgkmcnt(0)" ::: "memory")
#define MFMA16(a, b, c) __builtin_amdgcn_mfma_f32_16x16x32_bf16((a), (b), (c), 0, 0, 0)
__device__ __forceinline__ unsigned f2bf(float f) { unsigned u = __float_as_uint(f); return (u + 0x7fffu + ((u >> 16) & 1u)) >> 16; }
typedef float f32x2_t __attribute__((ext_vector_type(2)));
typedef __bf16 bf16x2_t __attribute__((ext_vector_type(2)));
__device__ __forceinline__ unsigned pk2(float lo, float hi) { const f32x2_t v = {lo, hi}; return __builtin_bit_cast(unsigned, __builtin_convertvector(v, bf16x2_t)); }
__device__ __forceinline__ float bflo(unsigned w) { return __uint_as_float(w << 16); }
__device__ __forceinline__ float bfhi(unsigned w) { return __uint_as_float(w & 0xffff0000u); }
__device__ __forceinline__ float wave_sum(float v) {
#pragma unroll
    for (int o = 1; o < 64; o <<= 1) v += __shfl_xor(v, o);
    return v;
}

#define XB_TMO      128
#define XB_XCNT(j)  (256  + 64 * (j))
#define XB_XSUB(j)  (1280 + 64 * (j))
#define XB_XGEN(j)  (2304 + 64 * (j))
#define XB_TOP      3328
#define XB_TOPGEN   3392
#define XCD_BAR_WORDS 3456
#define XB_SPIN_CAP (1u << 18)

__device__ __forceinline__ unsigned xb_ld(unsigned* p)              { return __hip_atomic_load(p, __ATOMIC_RELAXED, __HIP_MEMORY_SCOPE_AGENT); }
__device__ __forceinline__ unsigned xb_add(unsigned* p, unsigned v) { return __hip_atomic_fetch_add(p, v, __ATOMIC_RELAXED, __HIP_MEMORY_SCOPE_AGENT); }
__device__ __forceinline__ unsigned xb_xcc_id() { return (unsigned)__builtin_amdgcn_s_getreg((3 << 11) | 20) & 0xFu; }
#define XB_SPIN(cond, bar) do { unsigned _sp = 0; while (cond) { __builtin_amdgcn_s_sleep(1); \
    if ((++_sp & 255u) == 0u) { if (xb_ld(&(bar)[XB_TMO])) break; if (_sp > XB_SPIN_CAP) { atomicAdd(&(bar)[XB_TMO], 1u); break; } } } } while (0)

struct XcdBarrier {
    unsigned* bar; unsigned x;
    volatile LAS unsigned* st;
};

__device__ __forceinline__ XcdBarrier xcd_barrier_post(unsigned* bar, volatile LAS unsigned* st) {
    XcdBarrier b; b.bar = bar; b.x = xb_xcc_id(); b.st = st;
    if (threadIdx.x == 0) (void)xb_add(&bar[XB_XCNT(b.x)], 1u);
    return b;
}
__device__ __forceinline__ void xcd_barrier_complete(unsigned* bar, unsigned x, unsigned& nloc, unsigned& nx) {
    const unsigned G = gridDim.x * gridDim.y * gridDim.z;
    unsigned sum, cnt, mine, sp = 0u;
    for (;;) {
        sum = 0u; cnt = 0u; mine = 0u;
#pragma unroll
        for (unsigned j = 0; j < 16; ++j) { const unsigned c = xb_ld(&bar[XB_XCNT(j)]); sum += c; cnt += (c > 0u) ? 1u : 0u; mine = (j == x) ? c : mine; }
        if (sum == G) break;
        __builtin_amdgcn_s_sleep(1);
        if ((++sp & 255u) == 0u) { if (xb_ld(&bar[XB_TMO])) break; if (sp > XB_SPIN_CAP) { atomicAdd(&bar[XB_TMO], 1u); break; } }
    }
    nloc = mine > 0u ? mine : 1u; nx = cnt > 0u ? cnt : 1u;
}

__device__ __forceinline__ void xcd_barrier(const XcdBarrier& b) {
    asm volatile("s_waitcnt vmcnt(0)" ::: "memory");
    __syncthreads();
    if (threadIdx.x == 0) {
        unsigned* bar = b.bar;
        __builtin_amdgcn_s_waitcnt(0);
        unsigned nloc = b.st[0], nx = b.st[1];
        if (nloc == 0u) { xcd_barrier_complete(bar, b.x, nloc, nx); b.st[0] = nloc; b.st[1] = nx; }
        const unsigned old = xb_add(&bar[XB_XSUB(b.x)], 1u);
        const unsigned gen = old / nloc;
        if (old + 1u == (gen + 1u) * nloc) {
            __builtin_amdgcn_fence(__ATOMIC_RELEASE, "agent");
            asm volatile("s_waitcnt vmcnt(0)" ::: "memory");
            const unsigned og = xb_add(&bar[XB_TOP], 1u);
            const unsigned tg = og / nx;
            if (og + 1u == (tg + 1u) * nx) xb_add(&bar[XB_TOPGEN], 1u);
            else XB_SPIN(xb_ld(&bar[XB_TOPGEN]) == tg, bar);
            __builtin_amdgcn_fence(__ATOMIC_ACQUIRE, "agent");
            xb_add(&bar[XB_XGEN(b.x)], 1u);
            asm volatile("s_waitcnt vmcnt(0)" ::: "memory");
        } else {
            XB_SPIN(xb_ld(&bar[XB_XGEN(b.x)]) == gen, bar);
            __builtin_amdgcn_fence(__ATOMIC_ACQUIRE, "agent");
            asm volatile("s_waitcnt vmcnt(0)" ::: "memory");
        }
    }
    __syncthreads();
}
#define XL_CNT(j) (4096 + 64 * (j))
#define XL_GEN(j) (5120 + 64 * (j))
__device__ __forceinline__ void xcd_local_barrier(unsigned* bar, unsigned x, unsigned nloc) {
    asm volatile("s_waitcnt vmcnt(0)" ::: "memory");
    __syncthreads();
    if (threadIdx.x == 0) {
        __builtin_amdgcn_s_waitcnt(0);
        const unsigned old = xb_add(&bar[XL_CNT(x)], 1u);
        const unsigned gen = old / nloc;
        if (old + 1u == (gen + 1u) * nloc) xb_add(&bar[XL_GEN(x)], 1u);
        else XB_SPIN(xb_ld(&bar[XL_GEN(x)]) == gen, bar);
        __builtin_amdgcn_fence(__ATOMIC_ACQUIRE, "agent");
        asm volatile("s_waitcnt vmcnt(0)" ::: "memory");
    }
    __syncthreads();
}
struct Args { const float* in[15]; float* out; unsigned char* ws; int ph_lo, ph_hi, use_sync, pad; };

__device__ __forceinline__ size_t bt_tiled_off(int rho, int k, int K) {
    const int pn = rho >> 8, rr = rho & 255, h = rr >> 7, r128 = rr & 127;
    const int x = r128 & 31, R = (r128 & ~31) + 16 * ((x >> 2) & 1) + 4 * (x >> 3) + (x & 3);
    return (size_t)pn * 256 * K * 2 + (size_t)((k >> 6) * 2 + h) * 16384 + (size_t)pg8::lds_byte(R, k & 63);
}
__device__ __forceinline__ void tr_item(const float* W, int K, int N, bf16* WT, int kb, int nb, int row_base, const float* kscale, LAS float* scr, int lane) {
    const int k0 = 64 * kb, n0 = 64 * nb;
    f32x4 v[16]; float sc[16];
#pragma unroll
    for (int i = 0; i < 16; ++i) {
        const int kk = 4 * i + (lane >> 4);
        v[i] = *(const f32x4*)(W + (size_t)(k0 + kk) * N + n0 + 4 * (lane & 15));
        sc[i] = kscale ? kscale[k0 + kk] : 1.0f;
    }
#pragma unroll
    for (int i = 0; i < 16; ++i) {
        const int kk = 4 * i + (lane >> 4);
        LAS float* d = scr + kk * 65 + 4 * (lane & 15);
        d[0] = v[i][0] * sc[i]; d[1] = v[i][1] * sc[i]; d[2] = v[i][2] * sc[i]; d[3] = v[i][3] * sc[i];
    }
    LDS_WAIT();
    const int c = lane & 7;
#pragma unroll
    for (int j = 0; j < 8; ++j) {
        const int n = (lane >> 3) + 8 * j; const LAS float* s = scr + (8 * c) * 65 + n;
        u32x4 o; o.x = pk2(s[0 * 65], s[1 * 65]); o.y = pk2(s[2 * 65], s[3 * 65]); o.z = pk2(s[4 * 65], s[5 * 65]); o.w = pk2(s[6 * 65], s[7 * 65]);
        *(u32x4*)((unsigned char*)WT + bt_tiled_off(row_base + n, k0 + 8 * c, K)) = o;
    }
    LDS_WAIT();
}
__device__ __forceinline__ void prologue(const Args& a, LAS unsigned char* lds, int tid) {
    const int lane = tid & 63, wave = tid >> 6;
    const int gw = blockIdx.x * NWAVES + wave, NGW = gridDim.x * NWAVES;
    LAS float* scr = (LAS float*)(lds + wave * 16640);
    bf16* wbase = (bf16*)(a.ws + WS_W);
    constexpr int I_UP = 4 * 22, I_DN = 11 * 8, I_OUT = 4 * 8;
    constexpr int PER_LAYER = 7 * I_UP + I_OUT;
    const int kq = wave & 3, nh = wave >> 2;
    for (int it = blockIdx.x; it < DEPTH * PER_LAYER; it += gridDim.x) {
        const int l = it / PER_LAYER; int r = it % PER_LAYER;
        bf16* wl = wbase + (size_t)l * L_STRIDE;
        if (r < 2 * I_UP) { const int up = r >= I_UP; r -= up * I_UP; const int kb = 4 * (r / 22) + kq, nb = 2 * (r % 22) + nh, n0 = 64 * nb;
            tr_item(a.in[up ? 3 : 2] + (size_t)l * DM * FF, DM, FF, wl + O_GU1, kb, nb, 256 * (n0 >> 7) + (n0 & 127) + 128 * up, a.in[1] + l * DM, scr, lane); continue; }
        r -= 2 * I_UP;
        if (r < I_DN) { const int kb = 4 * (r / 8) + kq, nb = 2 * (r % 8) + nh; tr_item(a.in[4] + (size_t)l * FF * DM, FF, DM, wl + O_D1, kb, nb, 64 * nb, nullptr, scr, lane); continue; }
        r -= I_DN;
        if (r < I_UP) { const int kb = 4 * (r / 22) + kq, nb = 2 * (r % 22) + nh; tr_item(a.in[6] + (size_t)l * DM * DIN, DM, DIN, wl + O_IN, kb, nb, 64 * nb, a.in[5] + l * DM, scr, lane); continue; }
        r -= I_UP;
        if (r < I_OUT) { const int kb = 4 * (r / 8) + kq, nb = 2 * (r % 8) + nh; tr_item(a.in[9] + (size_t)l * DM * DM, DM, DM, wl + O_OUT, kb, nb, 64 * nb, nullptr, scr, lane); continue; }
        r -= I_OUT;
        if (r < 2 * I_UP) { const int up = r >= I_UP; r -= up * I_UP; const int kb = 4 * (r / 22) + kq, nb = 2 * (r % 22) + nh, n0 = 64 * nb;
            tr_item(a.in[up ? 12 : 11] + (size_t)l * DM * FF, DM, FF, wl + O_GU2, kb, nb, 256 * (n0 >> 7) + (n0 & 127) + 128 * up, a.in[10] + l * DM, scr, lane); continue; }
        r -= 2 * I_UP;
        { const int kb = 4 * (r / 8) + kq, nb = 2 * (r % 8) + nh; tr_item(a.in[13] + (size_t)l * FF * DM, FF, DM, wl + O_D2, kb, nb, 64 * nb, nullptr, scr, lane); }
    }
    bf16* hb = (bf16*)(a.ws + WS_HB); float* part = (float*)(a.ws + WS_PART);
    for (int m = gw; m < M; m += NGW) {
        const f32x4* xr = (const f32x4*)(a.in[0] + (size_t)m * DM) + lane; u32x2* o8 = (u32x2*)(hb + (size_t)m * DM) + lane;
        float s = 0.f;
#pragma unroll
        for (int j = 0; j < 4; ++j) { const f32x4 v = xr[64 * j]; s += (v[0] * v[0] + v[1] * v[1]) + (v[2] * v[2] + v[3] * v[3]); u32x2 w; w.x = pk2(v[0], v[1]); w.y = pk2(v[2], v[3]); *(u32x2*)((unsigned char*)hb + pg8::a_tiled_off(m, 4 * (lane + 64 * j), DM)) = w; }
        s = wave_sum(s);
        if (lane < 16) part[(size_t)m * 16 + lane] = lane == 0 ? s : 0.f;
    }
    float* rc = (float*)(a.ws + WS_ROPE); float* rsn = rc + SEQ * 64;
    for (int i = blockIdx.x * 512 + tid; i < SEQ * 64; i += gridDim.x * 512) {
        const int pos = i >> 6, d = i & 63;
        const float inv = powf(10000.0f, -(float)(2 * d) / 128.0f);
        const float ang = (float)pos * inv;
        double t = (double)ang * 0.15915494309189535; t -= rint(t);
        const float rev = (float)t;
        rc[i] = __builtin_amdgcn_cosf(rev); rsn[i] = __builtin_amdgcn_sinf(rev);
    }
}

typedef short v4i16_t __attribute__((ext_vector_type(4)));
__device__ __forceinline__ s16x4 vtr(const LAS unsigned char* p) { return __builtin_bit_cast(s16x4, __builtin_amdgcn_ds_read_tr16_b64_v4i16((LAS v4i16_t*)p)); }
__device__ __forceinline__ bf16x8 tr_frag(const LAS unsigned char* p0, const LAS unsigned char* p1) { const s16x4 lo = vtr(p0), hi = vtr(p1); return __builtin_shufflevector(lo, hi, 0, 1, 2, 3, 4, 5, 6, 7); }

constexpr int ATT_KP = 144, ATT_VP = 160;
__device__ __forceinline__ void att_unit(LAS unsigned char* lds, const bf16* proj, bf16* mix, const float* sinks, int unit, int tid) {
    const int kvh = unit & 1, nblk = (unit >> 1) & 15, b = unit >> 5, t0 = b * SEQ + nblk * 128;
    LAS unsigned char* Kimg = lds; LAS unsigned char* Vimg = lds + 256 * ATT_KP;
    const int w = tid >> 6, lane = tid & 63, fr = lane & 15, fq = lane >> 4;
    const int head = kvh * 4 + (w >> 1), half = w & 1;
    u32x4 kk[4], vv[4];
#pragma unroll
    for (int i = 0; i < 4; ++i) {
        const int idx = tid + 512 * i, key = idx >> 3, ch = idx & 7;
        kk[i] = (u32x4){0u, 0u, 0u, 0u}; vv[i] = (u32x4){0u, 0u, 0u, 0u};
        if (nblk > 0 || key >= 128) { const bf16* rp = proj + (size_t)(t0 - 128 + key) * DIN + kvh * 64 + 8 * ch; kk[i] = *(const u32x4*)(rp + 512); vv[i] = *(const u32x4*)(rp + 640); }
    }
    const bf16* qbase = proj + (size_t)(t0 + 64 * half + fr) * DIN + head * 64 + 8 * fq;
    bf16x8 qn0 = *(const bf16x8*)qbase, qn1 = *(const bf16x8*)(qbase + 32);
    const float sink = sinks[head];
    __builtin_amdgcn_sched_barrier(0);
#pragma unroll
    for (int i = 0; i < 4; ++i) {
        const int idx = tid + 512 * i, key = idx >> 3, ch = idx & 7;
        *(LAS u32x4*)(Kimg + key * ATT_KP + 16 * ch) = kk[i]; *(LAS u32x4*)(Vimg + key * ATT_VP + 16 * ch) = vv[i];
    }
    __syncthreads();
    const int trofs = (fr >> 2) * ATT_VP + 8 * (fr & 3);
    for (int mt = 0; mt < 4; ++mt) {
        const int q0 = 64 * half + 16 * mt;
        const bf16x8 qf0 = qn0, qf1 = qn1;
        if (mt < 3) { const bf16* qp = qbase + (size_t)(16 * (mt + 1)) * DIN; qn0 = *(const bf16x8*)qp; qn1 = *(const bf16x8*)(qp + 32); }
        __builtin_amdgcn_sched_barrier(0);
        f32x4 s[9];
#pragma unroll
        for (int kt = 0; kt < 9; ++kt) {
            const LAS unsigned char* kp = Kimg + (q0 + 16 * kt + fr) * ATT_KP + 16 * fq;
            const bf16x8 k0 = *(const LAS bf16x8*)kp, k1 = *(const LAS bf16x8*)(kp + 64);
            f32x4 c = (f32x4){0.f, 0.f, 0.f, 0.f};
            c = MFMA16(k0, qf0, c); c = MFMA16(k1, qf1, c); s[kt] = c;
        }
        const int qi = q0 + fr;
        float mx = sink;
#pragma unroll
        for (int kt = 0; kt < 9; ++kt) {
            const bool tile_ok = (nblk > 0) || (q0 + 16 * kt >= 128);
#pragma unroll
            for (int r = 0; r < 4; ++r) {
                const bool ok = tile_ok && (kt == 0 ? (4 * fq + r > fr) : (kt == 8 ? (4 * fq + r <= fr) : true));
                const float v = ok ? s[kt][r] * 0.125f : -1e30f;
                s[kt][r] = v; mx = fmaxf(mx, v);
            }
        }
        mx = fmaxf(mx, __shfl_xor(mx, 16)); mx = fmaxf(mx, __shfl_xor(mx, 32));
        float sum = 0.f;
#pragma unroll
        for (int kt = 0; kt < 9; ++kt)
#pragma unroll
            for (int r = 0; r < 4; ++r) { const float p = __expf(s[kt][r] - mx); s[kt][r] = p; sum += p; }
        sum += __shfl_xor(sum, 16); sum += __shfl_xor(sum, 32);
        const float inv = 1.0f / (sum + __expf(sink - mx));
        f32x4 o[4];
#pragma unroll
        for (int dt = 0; dt < 4; ++dt) o[dt] = (f32x4){0.f, 0.f, 0.f, 0.f};
#pragma unroll
        for (int p = 0; p < 5; ++p) {
            u32x4 pw; pw.x = pk2(s[2 * p][0] * inv, s[2 * p][1] * inv); pw.y = pk2(s[2 * p][2] * inv, s[2 * p][3] * inv);
            if (p < 4) { pw.z = pk2(s[2 * p + 1][0] * inv, s[2 * p + 1][1] * inv); pw.w = pk2(s[2 * p + 1][2] * inv, s[2 * p + 1][3] * inv); } else { pw.z = 0u; pw.w = 0u; }
            const bf16x8 pb = __builtin_bit_cast(bf16x8, pw);
#pragma unroll
            for (int dt = 0; dt < 4; ++dt) {
                const LAS unsigned char* vp = Vimg + (q0 + 32 * p + 4 * fq) * ATT_VP + 32 * dt + trofs;
                const s16x4 lo = vtr(vp); s16x4 hi = (s16x4){0, 0, 0, 0}; if (p < 4) hi = vtr(vp + 16 * ATT_VP);
                o[dt] = MFMA16(__builtin_shufflevector(lo, hi, 0, 1, 2, 3, 4, 5, 6, 7), pb, o[dt]);
            }
        }
        bf16* op = mix + (size_t)(t0 + q0 + fr) * DM + head * 64 + 4 * fq;
#pragma unroll
        for (int dt = 0; dt < 4; ++dt) { u32x2 w2; w2.x = pk2(o[dt][0], o[dt][1]); w2.y = pk2(o[dt][2], o[dt][3]); *(u32x2*)((unsigned char*)mix + pg8::a_tiled_off(t0 + q0 + fr, head * 64 + 16 * dt + 4 * fq, DM)) = w2; }
    }
    __syncthreads();
}

__device__ __forceinline__ float ret_log_gamma(int h) { return logf(1.0f - exp2f(-5.0f - (float)h)); }
constexpr int RET_P = 288;
template <bool ZETA>
__device__ __forceinline__ void ret_load_kv(LAS unsigned char* Kimg, LAS unsigned char* Vimg, const bf16* proj, const float* rc, const float* rsn, int t0, int n, int h, float lg, int tid) {
    u32x4 klo[2], khi[2], vv[4]; f32x4 kc[2][2], ks_[2][2];
#pragma unroll
    for (int i = 0; i < 2; ++i) {
        const int idx = tid + 512 * i, j = idx >> 3, dc = idx & 7;
        const bf16* kp = proj + (size_t)(t0 + j) * DIN + 1280 + h * 128 + 8 * dc;
        klo[i] = *(const u32x4*)kp; khi[i] = *(const u32x4*)(kp + 64);
        const int pos = n * 128 + j;
        kc[i][0] = *(const f32x4*)(rc + pos * 64 + 8 * dc); kc[i][1] = *(const f32x4*)(rc + pos * 64 + 8 * dc + 4);
        ks_[i][0] = *(const f32x4*)(rsn + pos * 64 + 8 * dc); ks_[i][1] = *(const f32x4*)(rsn + pos * 64 + 8 * dc + 4);
    }
#pragma unroll
    for (int i = 0; i < 4; ++i) { const int idx = tid + 512 * i, j = idx >> 4, vc = idx & 15; vv[i] = *(const u32x4*)(proj + (size_t)(t0 + j) * DIN + 1792 + h * 128 + 8 * vc); }
    __builtin_amdgcn_sched_barrier(0);
#pragma unroll
    for (int i = 0; i < 2; ++i) {
        const int idx = tid + 512 * i, j = idx >> 3, dc = idx & 7;
        const float ksc = ZETA ? 0.08838834764831845f : 0.08838834764831845f * __expf(-(float)j * lg);
        float r1[8], r2[8];
#pragma unroll
        for (int e = 0; e < 8; ++e) {
            const float x1 = (e & 1) ? bfhi(klo[i][e >> 1]) : bflo(klo[i][e >> 1]), x2 = (e & 1) ? bfhi(khi[i][e >> 1]) : bflo(khi[i][e >> 1]);
            const float c = kc[i][e >> 2][e & 3], sn = ks_[i][e >> 2][e & 3];
            r1[e] = (x1 * c - x2 * sn) * ksc; r2[e] = (x1 * sn + x2 * c) * ksc;
        }
        u32x4 w1, w2; w1.x = pk2(r1[0], r1[1]); w1.y = pk2(r1[2], r1[3]); w1.z = pk2(r1[4], r1[5]); w1.w = pk2(r1[6], r1[7]);
        w2.x = pk2(r2[0], r2[1]); w2.y = pk2(r2[2], r2[3]); w2.z = pk2(r2[4], r2[5]); w2.w = pk2(r2[6], r2[7]);
        *(LAS u32x4*)(Kimg + j * RET_P + 16 * dc) = w1; *(LAS u32x4*)(Kimg + j * RET_P + 128 + 16 * dc) = w2;
    }
#pragma unroll
    for (int i = 0; i < 4; ++i) {
        const int idx = tid + 512 * i, j = idx >> 4, vc = idx & 15;
        u32x4 v = vv[i];
        if (ZETA) { const float z = __expf((float)(127 - j) * lg);
            v.x = pk2(bflo(v.x) * z, bfhi(v.x) * z); v.y = pk2(bflo(v.y) * z, bfhi(v.y) * z); v.z = pk2(bflo(v.z) * z, bfhi(v.z) * z); v.w = pk2(bflo(v.w) * z, bfhi(v.w) * z); }
        *(LAS u32x4*)(Vimg + j * RET_P + 16 * vc) = v;
    }
}
__device__ __forceinline__ void r1_unit(LAS unsigned char* lds, const bf16* proj, float* kv, const float* rc, const float* rsn, int unit, int tid) {
    const int h = unit & 3, n = (unit >> 2) & 15, b = unit >> 6, t0 = b * SEQ + n * 128;
    LAS unsigned char* Kimg = lds; LAS unsigned char* Vimg = lds + 128 * RET_P;
    const float lg = ret_log_gamma(h);
    ret_load_kv<true>(Kimg, Vimg, proj, rc, rsn, t0, n, h, lg, tid);
    __syncthreads();
    const int w = tid >> 6, lane = tid & 63, fr = lane & 15, fq = lane >> 4;
    const int trofs = (fr >> 2) * RET_P + 8 * (fr & 3);
    f32x4 acc[8];
#pragma unroll
    for (int dt = 0; dt < 8; ++dt) acc[dt] = (f32x4){0.f, 0.f, 0.f, 0.f};
#pragma unroll
    for (int ks = 0; ks < 4; ++ks) {
        const int rb = (32 * ks + 8 * fq) * RET_P + trofs;
        const bf16x8 af = tr_frag(Vimg + rb + 32 * w, Vimg + rb + 4 * RET_P + 32 * w);
#pragma unroll
        for (int dt = 0; dt < 8; ++dt) { const bf16x8 bfr = tr_frag(Kimg + rb + 32 * dt, Kimg + rb + 4 * RET_P + 32 * dt); acc[dt] = MFMA16(af, bfr, acc[dt]); }
    }
    float* o = kv + (size_t)unit * 16384;
#pragma unroll
    for (int dt = 0; dt < 8; ++dt)
#pragma unroll
        for (int r = 0; r < 4; ++r) o[(16 * w + 4 * fq + r) * 128 + 16 * dt + fr] = acc[dt][r];
    __syncthreads();
}
__device__ __forceinline__ void scan_phase(const float* kv, bf16* prev, int tid, int vb) {
    for (int i = vb * 512 + tid; i < 32 * 4096; i += gridDim.x * 512) {
        const int chain = i >> 12, e4 = i & 4095, b = chain >> 2, h = chain & 3;
        const float dec = __expf(128.0f * ret_log_gamma(h));
        f32x4 st = (f32x4){0.f, 0.f, 0.f, 0.f}, kq[15];
#pragma unroll
        for (int n = 0; n < 15; ++n) kq[n] = *(const f32x4*)(kv + (size_t)((b * 16 + n) * 4 + h) * 16384 + 4 * e4);
        __builtin_amdgcn_sched_barrier(0);
#pragma unroll
        for (int n = 0; n < 16; ++n) {
            const size_t off = (size_t)((b * 16 + n) * 4 + h) * 16384 + 4 * e4;
            u32x2 w; w.x = pk2(st[0], st[1]); w.y = pk2(st[2], st[3]); *(u32x2*)(prev + off) = w;
            if (n < 15) st = st * dec + kq[n];
        }
    }
}
__device__ __forceinline__ void r2_unit(LAS unsigned char* lds, const bf16* proj, const bf16* prev, bf16* mix, const float* rc, const float* rsn, const float* gnw, int unit, int tid) {
    const int h = unit & 3, n = (unit >> 2) & 15, b = unit >> 6, t0 = b * SEQ + n * 128;
    LAS unsigned char* Kimg = lds; LAS unsigned char* Vimg = lds + 128 * RET_P;
    const float lg = ret_log_gamma(h);
    const int w = tid >> 6, lane = tid & 63, fr = lane & 15, fq = lane >> 4;
    const int qi = 16 * w + fr, tok = t0 + qi, pos = n * 128 + qi;
    const int trofs = (fr >> 2) * RET_P + 8 * (fr & 3);
    u32x4 qlo[2], qhi[2]; f32x4 qc[2][2], qs[2][2];
    {
        const bf16* qp = proj + (size_t)tok * DIN + 768 + h * 128 + 8 * fq;
#pragma unroll
        for (int ks = 0; ks < 2; ++ks) {
            qlo[ks] = *(const u32x4*)(qp + 32 * ks); qhi[ks] = *(const u32x4*)(qp + 32 * ks + 64);
            const float* cp = rc + pos * 64 + 32 * ks + 8 * fq; const float* sp = rsn + pos * 64 + 32 * ks + 8 * fq;
            qc[ks][0] = *(const f32x4*)cp; qc[ks][1] = *(const f32x4*)(cp + 4); qs[ks][0] = *(const f32x4*)sp; qs[ks][1] = *(const f32x4*)(sp + 4);
        }
    }
    u32x4 pv[4];
    if (n > 0) {
        const bf16* pp = prev + (size_t)unit * 16384;
#pragma unroll
        for (int i = 0; i < 4; ++i) { const int idx = tid + 512 * i; pv[i] = *(const u32x4*)(pp + (idx >> 4) * 128 + 8 * (idx & 15)); }
    }
    __builtin_amdgcn_sched_barrier(0);
    ret_load_kv<false>(Kimg, Vimg, proj, rc, rsn, t0, n, h, lg, tid);
    LAS unsigned char* Pimg = lds + 2 * 128 * RET_P;
    if (n > 0) {
#pragma unroll
        for (int i = 0; i < 4; ++i) { const int idx = tid + 512 * i; *(LAS u32x4*)(Pimg + (idx >> 4) * 272 + 16 * (idx & 15)) = pv[i]; }
    }
    __syncthreads();
    bf16x8 q[4];
    const float gq = __expf((float)qi * lg);
#pragma unroll
    for (int ks = 0; ks < 2; ++ks) {
        float r1[8], r2[8];
#pragma unroll
        for (int e = 0; e < 8; ++e) {
            const float x1 = (e & 1) ? bfhi(qlo[ks][e >> 1]) : bflo(qlo[ks][e >> 1]), x2 = (e & 1) ? bfhi(qhi[ks][e >> 1]) : bflo(qhi[ks][e >> 1]);
            const float c = qc[ks][e >> 2][e & 3], sn = qs[ks][e >> 2][e & 3];
            r1[e] = (x1 * c - x2 * sn) * gq; r2[e] = (x1 * sn + x2 * c) * gq;
        }
        u32x4 w1, w2; w1.x = pk2(r1[0], r1[1]); w1.y = pk2(r1[2], r1[3]); w1.z = pk2(r1[4], r1[5]); w1.w = pk2(r1[6], r1[7]);
        w2.x = pk2(r2[0], r2[1]); w2.y = pk2(r2[2], r2[3]); w2.z = pk2(r2[4], r2[5]); w2.w = pk2(r2[6], r2[7]);
        q[ks] = __builtin_bit_cast(bf16x8, w1); q[ks + 2] = __builtin_bit_cast(bf16x8, w2);
    }
    f32x4 y[8];
#pragma unroll
    for (int vt = 0; vt < 8; ++vt) y[vt] = (f32x4){0.f, 0.f, 0.f, 0.f};
    if (n > 0) {
#pragma unroll
        for (int ks = 0; ks < 4; ++ks)
#pragma unroll
            for (int vt = 0; vt < 8; ++vt) { const bf16x8 af = *(const LAS bf16x8*)(Pimg + (16 * vt + fr) * 272 + 64 * ks + 16 * fq); y[vt] = MFMA16(af, q[ks], y[vt]); }
        const float gam = __expf(lg);
#pragma unroll
        for (int vt = 0; vt < 8; ++vt) y[vt] = y[vt] * gam;
    }
    f32x4 s[8];
#pragma unroll
    for (int jt = 0; jt < 8; ++jt) {
        s[jt] = (f32x4){0.f, 0.f, 0.f, 0.f};
        if (jt <= w) {
#pragma unroll
            for (int ks = 0; ks < 4; ++ks) { const bf16x8 af = *(const LAS bf16x8*)(Kimg + (16 * jt + fr) * RET_P + 64 * ks + 16 * fq); s[jt] = MFMA16(af, q[ks], s[jt]); }
            if (jt == w) {
#pragma unroll
                for (int r = 0; r < 4; ++r) { const int j = 16 * jt + 4 * fq + r; s[jt][r] = (qi >= j) ? s[jt][r] : 0.f; }
            }
        }
    }
#pragma unroll
    for (int p = 0; p < 4; ++p) {
        if (2 * p <= w) {
            u32x4 pw; pw.x = pk2(s[2 * p][0], s[2 * p][1]); pw.y = pk2(s[2 * p][2], s[2 * p][3]); pw.z = pk2(s[2 * p + 1][0], s[2 * p + 1][1]); pw.w = pk2(s[2 * p + 1][2], s[2 * p + 1][3]);
            const bf16x8 pb = __builtin_bit_cast(bf16x8, pw);
#pragma unroll
            for (int vt = 0; vt < 8; ++vt) {
                const LAS unsigned char* vp = Vimg + (32 * p + 4 * fq) * RET_P + 32 * vt + trofs;
                y[vt] = MFMA16(tr_frag(vp, vp + 16 * RET_P), pb, y[vt]);
            }
        }
    }
    float sm = 0.f;
#pragma unroll
    for (int vt = 0; vt < 8; ++vt) sm += (y[vt][0] + y[vt][1]) + (y[vt][2] + y[vt][3]);
    sm += __shfl_xor(sm, 16); sm += __shfl_xor(sm, 32);
    const float mu = sm * (1.0f / 128.0f);
    float sq = 0.f;
#pragma unroll
    for (int vt = 0; vt < 8; ++vt) { y[vt] = y[vt] - mu; sq += (y[vt][0] * y[vt][0] + y[vt][1] * y[vt][1]) + (y[vt][2] * y[vt][2] + y[vt][3] * y[vt][3]); }
    sq += __shfl_xor(sq, 16); sq += __shfl_xor(sq, 32);
    const float rstd = 1.0f / sqrtf(sq * (1.0f / 128.0f) + 1e-5f);
    const bf16* gp = proj + (size_t)tok * DIN + 2304 + h * 128 + 4 * fq;
    bf16* op = mix + (size_t)tok * DM + 512 + h * 128 + 4 * fq;
    const float* gw = gnw + h * 128 + 4 * fq;
    u32x2 gva[8]; f32x4 wva[8];
#pragma unroll
    for (int vt = 0; vt < 8; ++vt) { gva[vt] = *(const u32x2*)(gp + 16 * vt); wva[vt] = *(const f32x4*)(gw + 16 * vt); }
    __builtin_amdgcn_sched_barrier(0);
#pragma unroll
    for (int vt = 0; vt < 8; ++vt) {
        const u32x2 gv = gva[vt]; const f32x4 wv = wva[vt];
        const float g0 = bflo(gv.x), g1 = bfhi(gv.x), g2 = bflo(gv.y), g3 = bfhi(gv.y);
        const float o0 = g0 * (y[vt][0] * rstd * wv[0]), o1 = g1 * (y[vt][1] * rstd * wv[1]);
        const float o2 = g2 * (y[vt][2] * rstd * wv[2]), o3 = g3 * (y[vt][3] * rstd * wv[3]);
        u32x2 w2; w2.x = pk2(o0, o1); w2.y = pk2(o2, o3); *(u32x2*)((unsigned char*)mix + pg8::a_tiled_off(tok, 512 + h * 128 + 16 * vt + 4 * fq, DM)) = w2;
    }
    __syncthreads();
}

__device__ __forceinline__ void final_phase(float* out, const bf16* hb, const float* part, const float* wf, int tid, int vb) {
    const int lane = tid & 63, G = gridDim.x;
    const int m_lo = (G == 256) ? vb * 64 + (tid >> 6) : vb * NWAVES + (tid >> 6), m_hi = (G == 256) ? vb * 64 + 64 : M, m_st = (G == 256) ? NWAVES : G * NWAVES;
    for (int m = m_lo; m < m_hi; m += m_st) {
        float s = lane < 16 ? part[(size_t)m * 16 + lane] : 0.f;
        s = wave_sum(s);
        const float rs = 1.0f / sqrtf(s * (1.0f / 1024.0f) + 1e-6f);
        const u32x2* hr = (const u32x2*)(hb + (size_t)m * DM) + lane; f32x4* xr = (f32x4*)(out + (size_t)m * DM) + lane; const f32x4* wr = (const f32x4*)wf + lane;
#pragma unroll
        for (int j = 0; j < 4; ++j) { const u32x2 hv = *(const u32x2*)((const unsigned char*)hb + pg8::a_tiled_off(m, 4 * (lane + 64 * j), DM)); const f32x4 v = (f32x4){bflo(hv.x), bfhi(hv.x), bflo(hv.y), bfhi(hv.y)}; xr[64 * j] = v * rs * wr[64 * j]; }
    }
}

constexpr int RTAB_OFF = 131072;
__device__ __forceinline__ void rstd_table(LAS unsigned char* lds, const float* part, int pm0, int pm1, int tid) {
    const int r = tid >> 1, hs = tid & 1;
    if (pm0 >= 0) {
        const int pmb = pm1 >= 0 ? pm1 : pm0;
        const float* p0 = part + (size_t)(pm0 * 256 + r) * 16 + 8 * hs; const float* p1 = part + (size_t)(pmb * 256 + r) * 16 + 8 * hs;
        const f32x4 a0 = *(const f32x4*)p0, b0 = *(const f32x4*)(p0 + 4), a1 = *(const f32x4*)p1, b1 = *(const f32x4*)(p1 + 4);
        float s0 = ((a0[0] + a0[1]) + (a0[2] + a0[3])) + ((b0[0] + b0[1]) + (b0[2] + b0[3]));
        float s1 = ((a1[0] + a1[1]) + (a1[2] + a1[3])) + ((b1[0] + b1[1]) + (b1[2] + b1[3]));
        s0 += __shfl_xor(s0, 1); s1 += __shfl_xor(s1, 1);
        if (hs == 0) { LAS float* rt = (LAS float*)(lds + RTAB_OFF); rt[r] = 1.0f / sqrtf(s0 * (1.0f / 1024.0f) + 1e-6f); rt[256 + r] = 1.0f / sqrtf(s1 * (1.0f / 1024.0f) + 1e-6f); }
    }
    __syncthreads();
}

__global__ void __launch_bounds__(NWAVES * 64, 2) fwd_kernel(Args a) {
    extern __shared__ __attribute__((aligned(16))) unsigned char lds_raw[];
    LAS unsigned char* lds = (LAS unsigned char*)lds_raw;
    const int G = gridDim.x;
#define BAR_CTL ((unsigned*)(a.ws + WS_CTL))
#define BAR_ST ((volatile LAS unsigned*)(lds + LDS_BARST))
#define BAR_X (a.use_sync ? xb_xcc_id() : 0u)
    if (a.use_sync) {
        if (threadIdx.x < 16) ((LAS unsigned*)(lds + LDS_BARST))[threadIdx.x] = 0u;
        __syncthreads();
        if (threadIdx.x == 0) BAR_ST[2] = xb_add(&BAR_CTL[XB_XCNT(xb_xcc_id())], 1u);
    }
#pragma nounroll
    for (int ph = a.ph_lo; ph < a.ph_hi; ++ph) {
        const int sidx = (ph == 0) ? 9 : ((ph == NPH - 1) ? 10 : (ph - 1) % 9);
        const int nrep = ((PROBE_REP_MASK >> sidx) & 1) ? 2 : 1;
#pragma nounroll
        for (int rep = 0; rep < nrep; ++rep) {
        int tid = threadIdx.x; asm volatile("" : "+v"(tid));
        const unsigned xmode = a.use_sync ? BAR_ST[3] : 0u, xrank = a.use_sync ? BAR_ST[2] : 0u;
        const int vcu = xmode ? (int)(xrank * 8u + BAR_X) : (int)blockIdx.x;
        const int vb = xmode ? (int)(BAR_X * 32u + xrank) : (int)blockIdx.x;
        size_t wsz = 0; asm volatile("" : "+s"(wsz)); unsigned char* ws = a.ws + wsz;
        bf16* hb = (bf16*)(ws + WS_HB); bf16* act = (bf16*)(ws + WS_ACT); bf16* mix = (bf16*)(ws + WS_MIX);
        float* part = (float*)(ws + WS_PART); float* kv = (float*)(ws + WS_KV); bf16* prev = (bf16*)(ws + WS_PREV);
        const float* rc = (const float*)(ws + WS_ROPE); const float* rsn = rc + SEQ * 64;
        if (ph == 0) prologue(a, lds, tid);
        else if (ph == NPH - 1) final_phase(a.out, hb, part, a.in[14], tid, vb);
        else {
            const int l = (ph - 1) / 9, s = (ph - 1) % 9;
            const bf16* wl = (const bf16*)(ws + WS_W) + (size_t)l * L_STRIDE;
            if (s == 0 || s == 7) {
                pg8::Gemm g{hb, wl + (s == 0 ? O_GU1 : O_GU2), M, 2 * FF, DM}; pg8::StaticOrder S; S.init(M, 2 * FF, G, vcu);
                pg8::Unit u0, uh; u0.pm = -1; uh.pm = -1; (void)S.next(0, u0); (void)S.next(S.nwg / S.G, uh);
                rstd_table(lds, part, u0.pm, uh.pm, tid);
                pg8::EpiSwiGLU E{act, FF, part, (const LAS float*)(lds + RTAB_OFF), u0.pm, uh.pm};
                pg8::gemm_phase<pg8::EpiSwiGLU, pg8::StaticOrder, true, true>(lds, g, S, E);
            } else if (s == 1 || s == 8 || s == 6) {
                const bool isout = (s == 6);
                pg8::Gemm g{isout ? mix : act, wl + (s == 1 ? O_D1 : (s == 8 ? O_D2 : O_OUT)), M, DM, isout ? DM : FF}; pg8::StaticOrder S; S.init(M, DM, G, vcu);
                pg8::EpiResid E{hb, part, (rep + 1 < nrep) ? 0.0f : (isout ? 1.0f : 0.5f)};
                pg8::gemm_phase<pg8::EpiResid, pg8::StaticOrder, true, true>(lds, g, S, E);
            } else if (s == 2) {
                pg8::Gemm g{hb, wl + O_IN, M, DIN, DM}; pg8::StaticOrder S; S.init(M, DIN, G, vcu);
                pg8::Unit u0; u0.pm = -1; (void)S.next(0, u0);
                rstd_table(lds, part, u0.pm, -1, tid);
                pg8::EpiScaleBf16 E{act, DIN, part, 9, (const LAS float*)(lds + RTAB_OFF), u0.pm};
                pg8::gemm_phase<pg8::EpiScaleBf16, pg8::StaticOrder, true, true>(lds, g, S, E);
            } else if (s == 3) {
                for (int u = vb; u < 256; u += G) att_unit(lds, act, mix, a.in[7] + l * 8, u, tid);
                if (G == 256) { for (int k = 0; k < 2; ++k) r1_unit(lds, act, kv, rc, rsn, (vb >> 5) * 64 + (vb & 31) + 32 * k, tid); }
                else for (int u = vb; u < 512; u += G) r1_unit(lds, act, kv, rc, rsn, u, tid);
            } else if (s == 4) {
                scan_phase(kv, prev, tid, vb);
            } else {
                if (G == 256) { for (int k = 0; k < 2; ++k) r2_unit(lds, act, prev, mix, rc, rsn, a.in[8] + l * 512, (vb >> 5) * 64 + (vb & 31) + 32 * k, tid); }
                else for (int u = vb; u < 512; u += G) r2_unit(lds, act, prev, mix, rc, rsn, a.in[8] + l * 512, u, tid);
            }
        }
        }
        if (ph + 1 < a.ph_hi && a.use_sync) {
            if (ph == 0) {
                if (G != 256) cg::this_grid().sync();
                else { XcdBarrier bar; bar.bar = BAR_CTL; bar.x = xb_xcc_id(); bar.st = BAR_ST; xcd_barrier(bar); }
                if (threadIdx.x == 0) {
                    unsigned nloc = 0u, nx = 0u, ok = (G == 256) ? 1u : 0u;
                    const unsigned myx = xb_xcc_id();
                    for (unsigned j = 0; j < 16; ++j) { const unsigned c = xb_ld(&BAR_CTL[XB_XCNT(j)]); nx += c ? 1u : 0u; if (j == myx) nloc = c; if (c != (j < 8u ? 32u : 0u)) ok = 0u; }
                    BAR_ST[0] = nloc ? nloc : 1u; BAR_ST[1] = nx ? nx : 1u; BAR_ST[3] = ok;
                }
                __syncthreads();
            } else if (BAR_ST[3]) xcd_local_barrier(BAR_CTL, xb_xcc_id(), BAR_ST[0]);
            else { XcdBarrier bar; bar.bar = BAR_CTL; bar.x = xb_xcc_id(); bar.st = BAR_ST; xcd_barrier(bar); }
        }
    }
}

extern "C" void kernel_launch(void* const* d_in, const int* in_sizes, int n_in, void* d_out, int out_size, void* d_ws, size_t ws_size, hipStream_t stream) {
    static int grid = 0;
    if (grid == 0) {
        if (n_in != 15 || out_size != M * DM || ws_size < WS_END) { fprintf(stderr, "kernel_launch: unexpected shapes (n_in %d out %d ws %zu)\n", n_in, out_size, ws_size); grid = -1; return; }
        if (hipFuncSetAttribute((const void*)fwd_kernel, hipFuncAttributeMaxDynamicSharedMemorySize, LDS_BYTES) != hipSuccess) { fprintf(stderr, "kernel_launch: hipFuncSetAttribute failed\n"); grid = -1; return; }
        int dev = 0, cus = 0, per_cu = 0;
        hipGetDevice(&dev); hipDeviceGetAttribute(&cus, hipDeviceAttributeMultiprocessorCount, dev);
        hipOccupancyMaxActiveBlocksPerMultiprocessor(&per_cu, (const void*)fwd_kernel, NWAVES * 64, LDS_BYTES);
        (void)hipGetLastError();
        if (per_cu < 1) per_cu = 1;
        grid = cus > 0 ? cus : 256;
    }
    if (grid < 0) return;
    if (hipMemsetAsync((char*)d_ws + WS_CTL, 0, CTL_ZERO_BYTES, stream) != hipSuccess) { fprintf(stderr, "kernel_launch: memset failed\n"); return; }
    Args a{};
    for (int i = 0; i < 15; ++i) a.in[i] = (const float*)d_in[i];
    a.out = (float*)d_out; a.ws = (unsigned char*)d_ws;
#if MK_MULTI
    for (int ph = 0; ph < NPH; ++ph) { a.ph_lo = ph; a.ph_hi = ph + 1; a.use_sync = 0; hipLaunchKernelGGL(fwd_kernel, dim3(grid), dim3(NWAVES * 64), LDS_BYTES, stream, a); }
#else
    a.ph_lo = 0; a.ph_hi = NPH; a.use_sync = 1;
    void* args[] = {&a};
    hipError_t e = hipLaunchCooperativeKernel((const void*)fwd_kernel, dim3(grid), dim3(NWAVES * 64), args, LDS_BYTES, stream);
    if (e != hipSuccess) fprintf(stderr, "cooperative launch failed: %s (grid %d)\n", hipGetErrorString(e), grid);
#endif
}
```

```cpp
#include <hip/hip_runtime.h>
#include <hip/hip_cooperative_groups.h>
#include <cstdio>
#include <cstdint>
namespace cg = cooperative_groups;
#ifndef MK_MULTI
#define MK_MULTI 0
#endif
#ifndef PROBE_REP_MASK
#define PROBE_REP_MASK 0
#endif
namespace pg8 {
#define PG8_LAS __attribute__((address_space(3)))
typedef unsigned short bf16_t;
typedef short bf16x8 __attribute__((ext_vector_type(8)));
typedef float f32x4 __attribute__((ext_vector_type(4)));
typedef unsigned u32x4 __attribute__((ext_vector_type(4)));
constexpr int BM = 256, BK = 64, HALF = 128, HTB = HALF * BK * 2  , STAGE_BYTES = 8 * HTB, NXCD = 8, WGM = 8;

__host__ __device__ __forceinline__ int lds_byte(int r, int c) { const int st = (r >> 4) * 2 + (c >> 5), rr = r & 15, cc = c & 31, ob = rr * 64 + cc * 2; return st * 1024 + (ob ^ (((ob >> 9) & 1) << 5)); }
__host__ __device__ __forceinline__ void stage_rc(int b, int& R, int& C) { const int st = b / 1024, sb = b % 1024, swz = sb ^ (((sb >> 9) & 1) << 5); R = (st >> 1) * 16 + swz / 64; C = (st & 1) * 32 + (swz % 64) / 2; }
__host__ __device__ __forceinline__ int perm32(int rho) { const int n = rho >> 4, i = rho & 15; return 8 * (i >> 2) + 4 * n + (i & 3); }

__host__ __device__ __forceinline__ size_t a_tiled_off(int m, int c, int K) { return (size_t)(m >> 8) * 256 * K * 2 + (size_t)((c >> 6) * 2 + ((m >> 7) & 1)) * 16384 + (size_t)lds_byte(m & 127, c & 63); }
struct Unit { int pm, pn, hf; };
struct Gemm { const bf16_t* A; const bf16_t* Bt; int M, N, K; };

struct StaticOrder {
    int nM, nN, nwg, G, c;
    __host__ __device__ void init(int M, int N, int G_, int c_) { nM = M / BM; nN = N / BM; nwg = nM * nN; G = G_; c = c_; }
    __host__ __device__ bool next(int i, Unit& u) const {
        long L = (long)i * G + c; u.hf = 0;
        const int nfull = nwg / G;
        if ((G % 16 == 0) && (nwg % G == G / 2) && i >= nfull) { if (i > nfull) return false; L = (long)nfull * G + ((c >> 4) << 3) + (c & 7); u.hf = 1 + ((c >> 3) & 1); }
        else if (L >= nwg) return false;
        int wgid = (int)L; { const int q = nwg / NXCD, r = nwg % NXCD, xcd = wgid % NXCD, off = wgid / NXCD; wgid = (xcd < r ? xcd * (q + 1) : r * (q + 1) + (xcd - r) * q) + off; }
        const int nig = WGM * nN, gid = wgid / nig, fm = gid * WGM, gsz = (nM - fm) < WGM ? (nM - fm) : WGM;
        u.pm = fm + ((wgid % nig) % gsz); u.pn = (wgid % nig) / gsz; return true;
    }
    __device__ __forceinline__ void a_ready(const Unit&) const {}
    __device__ __forceinline__ void done(const Unit&) const {}
};

__device__ __forceinline__ unsigned cvt_pk_bf16(float lo, float hi) { unsigned r; asm volatile("v_cvt_pk_bf16_f32 %0, %1, %2" : "=v"(r) : "v"(lo), "v"(hi)); return r; }
typedef float f32x2 __attribute__((ext_vector_type(2)));
typedef unsigned u32x2 __attribute__((ext_vector_type(2)));
constexpr int PART_N = 16;
__device__ __forceinline__ float row_rstd(const float* part, int row, int fq) {
    const f32x4 p = *(const f32x4*)(part + (size_t)row * PART_N + 4 * fq);
    float s = (p[0] + p[1]) + (p[2] + p[3]);
    s += __shfl_xor(s, 16); s += __shfl_xor(s, 32);
    return 1.0f / sqrtf(s * (1.0f / 1024.0f) + 1e-6f);
}
__device__ __forceinline__ float silu_f(float g) { return g * __builtin_amdgcn_rcpf(1.0f + __builtin_amdgcn_exp2f(-1.44269504f * g)); }
struct EpiSwiGLU {
    static constexpr bool PERM = true, AFTER_DRAIN = false;
    bf16_t* O; int ldo; const float* part; const PG8_LAS float* rtab; int rpm, rpm2;
    __device__ __forceinline__ void operator()(const f32x4 (&acc)[2][2][4][2], const Unit& u, int wr, int wc, int fr, int fq) const {
        const int row0 = u.pm * BM + (u.hf == 2 ? HALF : 0) + wr * 64 + fr, col0 = u.pn * HALF + wc * 32 + 8 * fq;
        float rsv[2][4];
        if (u.pm == rpm || u.pm == rpm2) {
            const PG8_LAS float* rt = rtab + (u.pm == rpm ? 0 : 256);
#pragma unroll
            for (int ai = 0; ai < 2; ++ai)
#pragma unroll
                for (int m = 0; m < 4; ++m) rsv[ai][m] = rt[(row0 - u.pm * BM + ai * HALF + m * 16) & 255];
        } else {
#pragma unroll
            for (int ai = 0; ai < 2; ++ai)
#pragma unroll
                for (int m = 0; m < 4; ++m) rsv[ai][m] = row_rstd(part, row0 + ai * HALF + m * 16, fq);
        }
#pragma unroll
        for (int ai = 0; ai < 2; ++ai) {
            if (ai == 1 && u.hf) break;
#pragma unroll
            for (int m = 0; m < 4; ++m) {
                const int row = row0 + ai * HALF + m * 16; const float rs = rsv[ai][m];
                const float rsc = rs * -1.44269504f, rs2 = rs * rs;
                unsigned wv[4];
#pragma unroll
                for (int n = 0; n < 2; ++n)
#pragma unroll
                    for (int e = 0; e < 2; ++e) {
                        const f32x2 g2 = {acc[ai][0][m][n][2 * e], acc[ai][0][m][n][2 * e + 1]}, u2 = {acc[ai][1][m][n][2 * e], acc[ai][1][m][n][2 * e + 1]};
                        const f32x2 t = g2 * rsc;
                        f32x2 d; d.x = __builtin_amdgcn_exp2f(t.x); d.y = __builtin_amdgcn_exp2f(t.y);
                        d = d + 1.0f;
                        f32x2 r; r.x = __builtin_amdgcn_rcpf(d.x); r.y = __builtin_amdgcn_rcpf(d.y);
                        const f32x2 o = ((g2 * u2) * r) * rs2;
                        wv[2 * n + e] = cvt_pk_bf16(o.x, o.y);
                    }
                u32x4 w; w.x = wv[0]; w.y = wv[1]; w.z = wv[2]; w.w = wv[3];
                *(u32x4*)((unsigned char*)O + a_tiled_off(row, col0, ldo)) = w;
            }
        }
    }
};
struct EpiScaleBf16 {
    static constexpr bool PERM = true, AFTER_DRAIN = false;
    bf16_t* O; int ldo; const float* part; int gate_pn; const PG8_LAS float* rtab; int rpm;
    __device__ __forceinline__ void operator()(const f32x4 (&acc)[2][2][4][2], const Unit& u, int wr, int wc, int fr, int fq) const {
        const int row0 = u.pm * BM + wr * 64 + fr, col0 = u.pn * BM + wc * 32 + 8 * fq;
        const bool gate = u.pn >= gate_pn;
        float rsv[2][4];
        if (u.pm == rpm) {
#pragma unroll
            for (int ai = 0; ai < 2; ++ai)
#pragma unroll
                for (int m = 0; m < 4; ++m) rsv[ai][m] = rtab[(row0 - u.pm * BM + ai * HALF + m * 16) & 255];
        } else {
#pragma unroll
            for (int ai = 0; ai < 2; ++ai)
#pragma unroll
                for (int m = 0; m < 4; ++m) rsv[ai][m] = row_rstd(part, row0 + ai * HALF + m * 16, fq);
        }
#pragma unroll
        for (int ai = 0; ai < 2; ++ai)
#pragma unroll
            for (int m = 0; m < 4; ++m) {
                const int row = row0 + ai * HALF + m * 16; const float rs = rsv[ai][m];
#pragma unroll
                for (int bj = 0; bj < 2; ++bj) {
                    f32x4 v0 = acc[ai][bj][m][0] * rs, v1 = acc[ai][bj][m][1] * rs;
                    if (gate) {
                        f32x4 d0 = v0 * -1.44269504f, d1 = v1 * -1.44269504f;
#pragma unroll
                        for (int e = 0; e < 4; ++e) { d0[e] = __builtin_amdgcn_exp2f(d0[e]); d1[e] = __builtin_amdgcn_exp2f(d1[e]); }
                        d0 = d0 + 1.0f; d1 = d1 + 1.0f;
#pragma unroll
                        for (int e = 0; e < 4; ++e) { d0[e] = __builtin_amdgcn_rcpf(d0[e]); d1[e] = __builtin_amdgcn_rcpf(d1[e]); }
                        v0 = v0 * d0; v1 = v1 * d1;
                    }
                    u32x4 w; w.x = cvt_pk_bf16(v0[0], v0[1]); w.y = cvt_pk_bf16(v0[2], v0[3]); w.z = cvt_pk_bf16(v1[0], v1[1]); w.w = cvt_pk_bf16(v1[2], v1[3]);
                    *(u32x4*)(O + (size_t)row * ldo + col0 + bj * HALF) = w;
                }
            }
    }
};
struct EpiResid {
    static constexpr bool PERM = true, AFTER_DRAIN = false;
    bf16_t* hb; float* part; float scale;
    __device__ __forceinline__ void operator()(const f32x4 (&acc)[2][2][4][2], const Unit& u, int wr, int wc, int fr, int fq) const {
        const int row0 = u.pm * BM + wr * 64 + fr, col0 = u.pn * BM + wc * 32 + 8 * fq;
#pragma unroll
        for (int am = 0; am < 4; ++am) {
            const int ai = am >> 1;
            u32x4 bw[4][2];
#pragma unroll
            for (int m = 2 * (am & 1); m < 2 * (am & 1) + 2; ++m)
#pragma unroll
                for (int bj = 0; bj < 2; ++bj) bw[m][bj] = *(const u32x4*)((const unsigned char*)hb + a_tiled_off(row0 + ai * HALF + m * 16, col0 + bj * HALF, 1024));
#pragma unroll
            for (int m = 2 * (am & 1); m < 2 * (am & 1) + 2; ++m) {
                const int row = row0 + ai * HALF + m * 16; float ss = 0.f;
#pragma unroll
                for (int bj = 0; bj < 2; ++bj) {
                    const size_t off = (size_t)row * 1024 + col0 + bj * HALF;
                    const u32x4 b = bw[m][bj];
                    const f32x4 b0 = (f32x4){__uint_as_float(b.x << 16), __uint_as_float(b.x & 0xffff0000u), __uint_as_float(b.y << 16), __uint_as_float(b.y & 0xffff0000u)};
                    const f32x4 b1 = (f32x4){__uint_as_float(b.z << 16), __uint_as_float(b.z & 0xffff0000u), __uint_as_float(b.w << 16), __uint_as_float(b.w & 0xffff0000u)};
                    const f32x4 h0 = b0 + acc[ai][bj][m][0] * scale, h1 = b1 + acc[ai][bj][m][1] * scale;
                    u32x4 w; w.x = cvt_pk_bf16(h0[0], h0[1]); w.y = cvt_pk_bf16(h0[2], h0[3]); w.z = cvt_pk_bf16(h1[0], h1[1]); w.w = cvt_pk_bf16(h1[2], h1[3]);
                    *(u32x4*)((unsigned char*)hb + a_tiled_off(row, col0 + bj * HALF, 1024)) = w;
                    ss += (h0[0] * h0[0] + h0[1] * h0[1]) + (h0[2] * h0[2] + h0[3] * h0[3]) + (h1[0] * h1[0] + h1[1] * h1[1]) + (h1[2] * h1[2] + h1[3] * h1[3]);
                }
                ss += __shfl_xor(ss, 16); ss += __shfl_xor(ss, 32);
                if (fq == 0) part[(size_t)row * PART_N + u.pn * 4 + wc] = ss;
            }
            asm volatile("" ::: "memory");
        }
    }
};
template <class Epi, class Sched, bool ALIGN_EPI = false, bool SP2 = false>
__device__ __forceinline__ void gemm_phase(PG8_LAS unsigned char* lds, const Gemm g, const Sched& S, const Epi& E) {
    int tid_ = threadIdx.x; asm volatile("" : "+v"(tid_)); const int tid = tid_, wid = __builtin_amdgcn_readfirstlane(tid >> 6), lane = tid & 63, wr = wid >> 2, wc = wid & 3, fr = lane & 15, fq = lane >> 4;
    const int K = g.K, nt = K / BK;
    unsigned voffA[2], voffB[2];
#pragma unroll
    for (int i = 0; i < 2; ++i) { int R, C; stage_rc(tid * 16 + i * 8192, R, C); const int Rb = Epi::PERM ? ((R & ~31) + perm32(R & 31)) : R;
        voffA[i] = (unsigned)(tid * 16 + i * 8192); voffB[i] = voffA[i]; (void)Rb; (void)R; (void)C; }
    const size_t kstep = 32768;
    const size_t hstep = 16384;
    const size_t tstep = (size_t)256 * K * 2;
    const size_t kstepB = 32768, hstepB = 16384;
    const unsigned ldsw = (unsigned)wid * 1024u;
    const int aoff = lds_byte(wr * 64 + fr, fq * 8), boff = lds_byte(wc * 32 + fr, fq * 8);
#define PG8_SA(b, h) (((b) * 2 + (h)) * HTB)
#define PG8_SB(b, h) ((4 + (b) * 2 + (h)) * HTB)
#define PG8_STAGE(bufoff, gbase, voff) do { _Pragma("unroll") for (int _i = 0; _i < 2; ++_i) \
        __builtin_amdgcn_global_load_lds((const unsigned*)((const char*)(gbase) + (voff)[_i]), (PG8_LAS unsigned*)(lds + (bufoff) + ldsw + _i * 8192), 16, 0, 0); } while (0)
#define PG8_LDA(dst, b, h) do { _Pragma("unroll") for (int m = 0; m < 4; ++m) _Pragma("unroll") for (int k = 0; k < 2; ++k) dst[m][k] = *(const PG8_LAS bf16x8*)(lds + PG8_SA(b, h) + aoff + m * 2048 + k * 1024); } while (0)
#define PG8_LDB(dst, b, h) do { _Pragma("unroll") for (int n = 0; n < 2; ++n) _Pragma("unroll") for (int k = 0; k < 2; ++k) dst[n][k] = *(const PG8_LAS bf16x8*)(lds + PG8_SB(b, h) + boff + n * 2048 + k * 1024); } while (0)
#define PG8_MMA(ai, bj, At, Bt) do { __builtin_amdgcn_s_setprio(1); _Pragma("unroll") for (int m = 0; m < 4; ++m) _Pragma("unroll") for (int n = 0; n < 2; ++n) _Pragma("unroll") for (int k = 0; k < 2; ++k) \
        acc[ai][bj][m][n] = __builtin_amdgcn_mfma_f32_16x16x32_bf16(Bt[n][k], At[m][k], acc[ai][bj][m][n], 0, 0, 0); __builtin_amdgcn_s_setprio(0); } while (0)
#define PG8_WAIT_V(n) asm volatile("s_waitcnt vmcnt(" #n ")" ::: "memory")
#define PG8_WAIT_L(n) asm volatile("s_waitcnt lgkmcnt(" #n ")" ::: "memory")
#define PG8_BAR __builtin_amdgcn_s_barrier()
#define PG8_SCHED __builtin_amdgcn_sched_barrier(0)
    Unit cur, nxt; int ui = 0;
    if (!S.next(0, cur)) return;
    f32x4 acc[2][2][4][2];
#pragma unroll
    for (int a = 0; a < 2; ++a)
#pragma unroll
        for (int b = 0; b < 2; ++b)
#pragma unroll
            for (int m = 0; m < 4; ++m)
#pragma unroll
                for (int n = 0; n < 2; ++n) acc[a][b][m][n] = (f32x4){0.f, 0.f, 0.f, 0.f};
    bf16x8 At[4][2], B0[2][2], B1[2][2];
    const char* cA = (const char*)g.A + (size_t)cur.pm * tstep + (cur.hf == 2 ? hstep : (size_t)0); const char* cB = (const char*)g.Bt + (size_t)cur.pn * tstep;
    S.a_ready(cur);
    if constexpr (SP2) {
        PG8_STAGE(PG8_SB(0, 0), cB, voffB); PG8_STAGE(PG8_SB(0, 1), cB + hstepB, voffB); PG8_STAGE(PG8_SA(0, 0), cA, voffA); PG8_STAGE(PG8_SA(0, 1), cA + hstep, voffA);
        if (wr == 1) PG8_BAR;
        PG8_WAIT_V(2); PG8_BAR;
        PG8_STAGE(PG8_SB(1, 0), cB + kstepB, voffB); PG8_STAGE(PG8_SA(1, 0), cA + kstep, voffA); PG8_STAGE(PG8_SB(1, 1), cB + hstepB + kstepB, voffB);
        PG8_WAIT_V(6); PG8_BAR;
    } else {
        PG8_STAGE(PG8_SB(0, 0), cB, voffB); PG8_STAGE(PG8_SA(0, 0), cA, voffA); PG8_STAGE(PG8_SB(0, 1), cB + hstepB, voffB); PG8_STAGE(PG8_SA(0, 1), cA + hstep, voffA);
        if (wr == 1) PG8_BAR;
        PG8_WAIT_V(4); PG8_BAR;
        PG8_STAGE(PG8_SB(1, 0), cB + kstepB, voffB); PG8_STAGE(PG8_SA(1, 0), cA + kstep, voffA); PG8_STAGE(PG8_SB(1, 1), cB + hstepB + kstepB, voffB);
        PG8_WAIT_V(6); PG8_BAR;
    }
    for (;;) {
        const bool has_next = S.next(ui + 1, nxt);
        const char* nA = has_next ? (const char*)g.A + (size_t)nxt.pm * tstep + (nxt.hf == 2 ? hstep : (size_t)0) : cA; const char* nB = has_next ? (const char*)g.Bt + (size_t)nxt.pn * tstep : cB;
        for (int t = 0; t < nt; t += 2) {
            const bool last = (t == nt - 2);
            const char* a1 = cA + (size_t)(t + 1) * kstep;
            const char* a2 = last ? nA : cA + (size_t)(t + 2) * kstep; const char* b2 = last ? nB : cB + (size_t)(t + 2) * kstepB;
            const char* a3 = a2 + kstep; const char* b3 = b2 + kstepB;
            if (last && has_next) S.a_ready(nxt);
            if constexpr (SP2) {
            PG8_LDB(B0, 0, 0); PG8_LDB(B1, 0, 1); PG8_SCHED; PG8_LDA(At, 0, 0); PG8_STAGE(PG8_SA(1, 1), a1 + hstep, voffA);
            PG8_WAIT_V(8); PG8_WAIT_L(0); PG8_BAR; PG8_MMA(0, 0, At, B0); PG8_MMA(0, 1, At, B1); PG8_BAR; PG8_SCHED;
            PG8_LDA(At, 0, 1); PG8_STAGE(PG8_SB(0, 0), b2, voffB); PG8_STAGE(PG8_SB(0, 1), b2 + hstepB, voffB); PG8_STAGE(PG8_SA(0, 0), a2, voffA);
            PG8_WAIT_V(8); PG8_WAIT_L(0); PG8_BAR; if (!cur.hf) { PG8_MMA(1, 0, At, B0); PG8_MMA(1, 1, At, B1); } PG8_BAR; PG8_SCHED;
            PG8_LDB(B0, 1, 0); PG8_LDB(B1, 1, 1); PG8_SCHED; PG8_LDA(At, 1, 0); PG8_STAGE(PG8_SA(0, 1), a2 + hstep, voffA);
            PG8_WAIT_V(8); PG8_WAIT_L(0); PG8_BAR; PG8_MMA(0, 0, At, B0); PG8_MMA(0, 1, At, B1); PG8_BAR; PG8_SCHED;
            PG8_LDA(At, 1, 1); PG8_STAGE(PG8_SB(1, 0), b3, voffB); PG8_STAGE(PG8_SB(1, 1), b3 + hstepB, voffB); PG8_STAGE(PG8_SA(1, 0), a3, voffA);
            PG8_WAIT_V(8); PG8_WAIT_L(0); PG8_BAR; if (!cur.hf) { PG8_MMA(1, 0, At, B0); PG8_MMA(1, 1, At, B1); } PG8_BAR; PG8_SCHED;
            } else {
            PG8_LDB(B0, 0, 0); PG8_SCHED; PG8_LDA(At, 0, 0); PG8_STAGE(PG8_SA(1, 1), a1 + hstep, voffA);
            PG8_WAIT_L(8); PG8_BAR; PG8_WAIT_L(0); PG8_MMA(0, 0, At, B0); PG8_BAR; PG8_SCHED;
            PG8_LDB(B1, 0, 1); PG8_STAGE(PG8_SB(0, 0), b2, voffB);
            PG8_BAR; PG8_WAIT_L(0); PG8_MMA(0, 1, At, B1); PG8_BAR;
            PG8_LDA(At, 0, 1); PG8_STAGE(PG8_SA(0, 0), a2, voffA);
            PG8_BAR; PG8_WAIT_L(0); PG8_MMA(1, 0, At, B0); PG8_BAR; PG8_SCHED;
            PG8_STAGE(PG8_SB(0, 1), b2 + hstepB, voffB);
            PG8_WAIT_V(6); PG8_BAR; PG8_MMA(1, 1, At, B1); PG8_BAR;
            PG8_LDB(B0, 1, 0); PG8_SCHED; PG8_LDA(At, 1, 0); PG8_STAGE(PG8_SA(0, 1), a2 + hstep, voffA);
            PG8_WAIT_L(8); PG8_BAR; PG8_WAIT_L(0); PG8_MMA(0, 0, At, B0); PG8_BAR; PG8_SCHED;
            PG8_LDB(B1, 1, 1); PG8_STAGE(PG8_SB(1, 0), b3, voffB);
            PG8_BAR; PG8_WAIT_L(0); PG8_MMA(0, 1, At, B1); PG8_BAR;
            PG8_LDA(At, 1, 1); PG8_STAGE(PG8_SA(1, 0), a3, voffA);
            PG8_BAR; PG8_WAIT_L(0); PG8_MMA(1, 0, At, B0); PG8_BAR; PG8_SCHED;
            PG8_STAGE(PG8_SB(1, 1), b3 + hstepB, voffB);
            PG8_WAIT_V(6); PG8_BAR; PG8_MMA(1, 1, At, B1); PG8_BAR;
            }
        }
        if constexpr (ALIGN_EPI) { if (wr == 0) PG8_BAR; }
        if constexpr (!Epi::AFTER_DRAIN) { E(acc, cur, wr, wc, fr, fq); S.done(cur); }
        if (!has_next) break;
#pragma unroll
        for (int a = 0; a < 2; ++a)
#pragma unroll
            for (int b = 0; b < 2; ++b)
#pragma unroll
                for (int m = 0; m < 4; ++m)
#pragma unroll
                    for (int n = 0; n < 2; ++n) acc[a][b][m][n] = (f32x4){0.f, 0.f, 0.f, 0.f};
        cur = nxt; cA = nA; cB = nB; ++ui;
        if constexpr (ALIGN_EPI) { if (wr == 1) PG8_BAR; }
    }
    PG8_WAIT_V(0);
    if constexpr (!ALIGN_EPI) { if (wr == 0) PG8_BAR; }
    PG8_BAR;
    if constexpr (Epi::AFTER_DRAIN) { E.fused(acc, cur, wr, wc, fr, fq, lds, wid, lane); S.done(cur); }
#undef PG8_SA
#undef PG8_SB
#undef PG8_STAGE
#undef PG8_LDA
#undef PG8_LDB
#undef PG8_MMA
#undef PG8_WAIT_V
#undef PG8_WAIT_L
#undef PG8_BAR
#undef PG8_SCHED
}
}
constexpr int NWAVES = 8;
constexpr int BATCH = 8, SEQ = 2048, DM = 1024, FF = 2816, DIN = 2816, DEPTH = 4;
constexpr int M = BATCH * SEQ;
constexpr int NPH = 2 + 9 * DEPTH;
constexpr size_t MiB = 1u << 20;
constexpr size_t WS_CTL = 0, CTL_ZERO_BYTES = 32768;
constexpr size_t WS_ROPE = 1 * MiB;
constexpr size_t WS_PART = 2 * MiB;
constexpr size_t WS_W = 4 * MiB;
constexpr size_t E_GU = (size_t)2 * FF * DM, E_DN = (size_t)DM * FF, E_IN = (size_t)DIN * DM, E_OUT = (size_t)DM * DM;
constexpr size_t O_GU1 = 0, O_D1 = E_GU, O_IN = O_D1 + E_DN, O_OUT = O_IN + E_IN, O_GU2 = O_OUT + E_OUT, O_D2 = O_GU2 + E_GU, L_STRIDE = O_D2 + E_DN;
constexpr size_t WS_HB = 166 * MiB;
constexpr size_t WS_ACT = 198 * MiB;
constexpr size_t WS_MIX = 286 * MiB;
constexpr size_t WS_KV = 318 * MiB;
constexpr size_t WS_PREV = 350 * MiB;
constexpr size_t WS_END = 366 * MiB;
static_assert(WS_W + DEPTH * L_STRIDE * 2 <= WS_HB, "weights fit");
constexpr int LDS_BYTES = 147456, LDS_BARST = LDS_BYTES - 64;

#define LAS __attribute__((address_space(3)))
typedef unsigned short bf16;
typedef float f32x4 __attribute__((ext_vector_type(4)));
typedef short bf16x8 __attribute__((ext_vector_type(8)));
typedef short s16x4 __attribute__((ext_vector_type(4)));
typedef unsigned u32x4 __attribute__((ext_vector_type(4)));
typedef unsigned u32x2 __attribute__((ext_vector_type(2)));
#define LDS_WAIT() asm volatile("s_waitcnt lgkmcnt(0)" ::: "memory")
#define MFMA16(a, b, c) __builtin_amdgcn_mfma_f32_16x16x32_bf16((a), (b), (c), 0, 0, 0)
__device__ __forceinline__ unsigned f2bf(float f) { unsigned u = __float_as_uint(f); return (u + 0x7fffu + ((u >> 16) & 1u)) >> 16; }
typedef float f32x2_t __attribute__((ext_vector_type(2)));
typedef __bf16 bf16x2_t __attribute__((ext_vector_type(2)));
__device__ __forceinline__ unsigned pk2(float lo, float hi) { const f32x2_t v = {lo, hi}; return __builtin_bit_cast(unsigned, __builtin_convertvector(v, bf16x2_t)); }
__device__ __forceinline__ float bflo(unsigned w) { return __uint_as_float(w << 16); }
__device__ __forceinline__ float bfhi(unsigned w) { return __uint_as_float(w & 0xffff0000u); }
__device__ __forceinline__ float wave_sum(float v) {
#pragma unroll
    for (int o = 1; o < 64; o <<= 1) v += __shfl_xor(v, o);
    return v;
}

#define XB_TMO      128
#define XB_XCNT(j)  (256  + 64 * (j))
#define XB_XSUB(j)  (1280 + 64 * (j))
#define XB_XGEN(j)  (2304 + 64 * (j))
#define XB_TOP      3328
#define XB_TOPGEN   3392
#define XCD_BAR_WORDS 3456
#define XB_SPIN_CAP (1u << 18)

__device__ __forceinline__ unsigned xb_ld(unsigned* p)              { return __hip_atomic_load(p, __ATOMIC_RELAXED, __HIP_MEMORY_SCOPE_AGENT); }
__device__ __forceinline__ unsigned xb_add(unsigned* p, unsigned v) { return __hip_atomic_fetch_add(p, v, __ATOMIC_RELAXED, __HIP_MEMORY_SCOPE_AGENT); }
__device__ __forceinline__ unsigned xb_xcc_id() { return (unsigned)__builtin_amdgcn_s_getreg((3 << 11) | 20) & 0xFu; }
#define XB_SPIN(cond, bar) do { unsigned _sp = 0; while (cond) { __builtin_amdgcn_s_sleep(1); \
    if ((++_sp & 255u) == 0u) { if (xb_ld(&(bar)[XB_TMO])) break; if (_sp > XB_SPIN_CAP) { atomicAdd(&(bar)[XB_TMO], 1u); break; } } } } while (0)

struct XcdBarrier {
    unsigned* bar; unsigned x;
    volatile LAS unsigned* st;
};

__device__ __forceinline__ XcdBarrier xcd_barrier_post(unsigned* bar, volatile LAS unsigned* st) {
    XcdBarrier b; b.bar = bar; b.x = xb_xcc_id(); b.st = st;
    if (threadIdx.x == 0) (void)xb_add(&bar[XB_XCNT(b.x)], 1u);
    return b;
}
__device__ __forceinline__ void xcd_barrier_complete(unsigned* bar, unsigned x, unsigned& nloc, unsigned& nx) {
    const unsigned G = gridDim.x * gridDim.y * gridDim.z;
    unsigned sum, cnt, mine, sp = 0u;
    for (;;) {
        sum = 0u; cnt = 0u; mine = 0u;
#pragma unroll
        for (unsigned j = 0; j < 16; ++j) { const unsigned c = xb_ld(&bar[XB_XCNT(j)]); sum += c; cnt += (c > 0u) ? 1u : 0u; mine = (j == x) ? c : mine; }
        if (sum == G) break;
        __builtin_amdgcn_s_sleep(1);
        if ((++sp & 255u) == 0u) { if (xb_ld(&bar[XB_TMO])) break; if (sp > XB_SPIN_CAP) { atomicAdd(&bar[XB_TMO], 1u); break; } }
    }
    nloc = mine > 0u ? mine : 1u; nx = cnt > 0u ? cnt : 1u;
}

__device__ __forceinline__ void xcd_barrier(const XcdBarrier& b) {
    asm volatile("s_waitcnt vmcnt(0)" ::: "memory");
    __syncthreads();
    if (threadIdx.x == 0) {
        unsigned* bar = b.bar;
        __builtin_amdgcn_s_waitcnt(0);
        unsigned nloc = b.st[0], nx = b.st[1];
        if (nloc == 0u) { xcd_barrier_complete(bar, b.x, nloc, nx); b.st[0] = nloc; b.st[1] = nx; }
        const unsigned old = xb_add(&bar[XB_XSUB(b.x)], 1u);
        const unsigned gen = old / nloc;
        if (old + 1u == (gen + 1u) * nloc) {
            __builtin_amdgcn_fence(__ATOMIC_RELEASE, "agent");
            asm volatile("s_waitcnt vmcnt(0)" ::: "memory");
            const unsigned og = xb_add(&bar[XB_TOP], 1u);
            const unsigned tg = og / nx;
            if (og + 1u == (tg + 1u) * nx) xb_add(&bar[XB_TOPGEN], 1u);
            else XB_SPIN(xb_ld(&bar[XB_TOPGEN]) == tg, bar);
            __builtin_amdgcn_fence(__ATOMIC_ACQUIRE, "agent");
            xb_add(&bar[XB_XGEN(b.x)], 1u);
            asm volatile("s_waitcnt vmcnt(0)" ::: "memory");
        } else {
            XB_SPIN(xb_ld(&bar[XB_XGEN(b.x)]) == gen, bar);
            __builtin_amdgcn_fence(__ATOMIC_ACQUIRE, "agent");
            asm volatile("s_waitcnt vmcnt(0)" ::: "memory");
        }
    }
    __syncthreads();
}
#define XL_CNT(j) (4096 + 64 * (j))
#define XL_GEN(j) (5120 + 64 * (j))
__device__ __forceinline__ void xcd_local_barrier(unsigned* bar, unsigned x, unsigned nloc) {
    asm volatile("s_waitcnt vmcnt(0)" ::: "memory");
    __syncthreads();
    if (threadIdx.x == 0) {
        __builtin_amdgcn_s_waitcnt(0);
        const unsigned old = xb_add(&bar[XL_CNT(x)], 1u);
        const unsigned gen = old / nloc;
        if (old + 1u == (gen + 1u) * nloc) xb_add(&bar[XL_GEN(x)], 1u);
        else XB_SPIN(xb_ld(&bar[XL_GEN(x)]) == gen, bar);
        __builtin_amdgcn_fence(__ATOMIC_ACQUIRE, "agent");
        asm volatile("s_waitcnt vmcnt(0)" ::: "memory");
    }
    __syncthreads();
}
struct Args { const float* in[15]; float* out; unsigned char* ws; int ph_lo, ph_hi, use_sync, pad; };

__device__ __forceinline__ size_t bt_tiled_off(int rho, int k, int K) {
    const int pn = rho >> 8, rr = rho & 255, h = rr >> 7, r128 = rr & 127;
    const int x = r128 & 31, R = (r128 & ~31) + 16 * ((x >> 2) & 1) + 4 * (x >> 3) + (x & 3);
    return (size_t)pn * 256 * K * 2 + (size_t)((k >> 6) * 2 + h) * 16384 + (size_t)pg8::lds_byte(R, k & 63);
}
__device__ __forceinline__ void tr_item(const float* W, int K, int N, bf16* WT, int kb, int nb, int row_base, const float* kscale, LAS float* scr, int lane, int slice) {
    const int k0 = 64 * kb, n0 = 64 * nb;
    if (slice >= 0) {
        const int kk0 = k0 + 8 * slice; float v8[8];
#pragma unroll
        for (int e = 0; e < 8; ++e) v8[e] = W[(size_t)(kk0 + e) * N + n0 + lane] * (kscale ? kscale[kk0 + e] : 1.0f);
        u32x4 o; o.x = pk2(v8[0], v8[1]); o.y = pk2(v8[2], v8[3]); o.z = pk2(v8[4], v8[5]); o.w = pk2(v8[6], v8[7]);
        *(u32x4*)((unsigned char*)WT + bt_tiled_off(row_base + lane, kk0, K)) = o;
        return;
    }
    f32x4 v[16]; float sc[16];
#pragma unroll
    for (int i = 0; i < 16; ++i) {
        const int kk = 4 * i + (lane >> 4);
        v[i] = *(const f32x4*)(W + (size_t)(k0 + kk) * N + n0 + 4 * (lane & 15));
        sc[i] = kscale ? kscale[k0 + kk] : 1.0f;
    }
#pragma unroll
    for (int i = 0; i < 16; ++i) {
        const int kk = 4 * i + (lane >> 4);
        LAS float* d = scr + kk * 65 + 4 * (lane & 15);
        d[0] = v[i][0] * sc[i]; d[1] = v[i][1] * sc[i]; d[2] = v[i][2] * sc[i]; d[3] = v[i][3] * sc[i];
    }
    LDS_WAIT();
    const int c = lane & 7;
#pragma unroll
    for (int j = 0; j < 8; ++j) {
        const int n = (lane >> 3) + 8 * j; const LAS float* s = scr + (8 * c) * 65 + n;
        u32x4 o; o.x = pk2(s[0 * 65], s[1 * 65]); o.y = pk2(s[2 * 65], s[3 * 65]); o.z = pk2(s[4 * 65], s[5 * 65]); o.w = pk2(s[6 * 65], s[7 * 65]);
        *(u32x4*)((unsigned char*)WT + bt_tiled_off(row_base + n, k0 + 8 * c, K)) = o;
    }
    LDS_WAIT();
}
__device__ __forceinline__ void prologue(const Args& a, LAS unsigned char* lds, int tid) {
    const int lane = tid & 63, wave = tid >> 6;
    const int gw = blockIdx.x * NWAVES + wave, NGW = gridDim.x * NWAVES;
    LAS float* scr = (LAS float*)(lds + wave * 16640);
    bf16* wbase = (bf16*)(a.ws + WS_W);
    constexpr int I_UP = 4 * 22, I_DN = 11 * 8, I_OUT = 4 * 8;
    constexpr int PER_LAYER = 7 * I_UP + I_OUT;
    constexpr int TOTAL = DEPTH * PER_LAYER;
    const int Gx = (int)gridDim.x, nwhole = TOTAL / Gx, nmain = nwhole * Gx, nslices = 64 * (TOTAL - nmain);
    const int niter = nwhole + (gw < nslices ? (nslices - gw + NGW - 1) / NGW : 0);
    for (int kit = 0; kit < niter; ++kit) {
        const bool tail = (kit >= nwhole);
        const int tsl = gw + (kit - nwhole) * NGW;
        const int it = tail ? nmain + (tsl >> 6) : (int)blockIdx.x + kit * Gx;
        const int sub = (tsl >> 3) & 7, slice = tail ? (tsl & 7) : -1;
        const int kq = tail ? (sub & 3) : (wave & 3), nh = tail ? (sub >> 2) : (wave >> 2);
        const int l = it / PER_LAYER; int r = it % PER_LAYER;
        bf16* wl = wbase + (size_t)l * L_STRIDE;
        if (r < 2 * I_UP) { const int up = r >= I_UP; r -= up * I_UP; const int kb = 4 * (r / 22) + kq, nb = 2 * (r % 22) + nh, n0 = 64 * nb;
            tr_item(a.in[up ? 3 : 2] + (size_t)l * DM * FF, DM, FF, wl + O_GU1, kb, nb, 256 * (n0 >> 7) + (n0 & 127) + 128 * up, a.in[1] + l * DM, scr, lane, slice); continue; }
        r -= 2 * I_UP;
        if (r < I_DN) { const int kb = 4 * (r / 8) + kq, nb = 2 * (r % 8) + nh; tr_item(a.in[4] + (size_t)l * FF * DM, FF, DM, wl + O_D1, kb, nb, 64 * nb, nullptr, scr, lane, slice); continue; }
        r -= I_DN;
        if (r < I_UP) { const int kb = 4 * (r / 22) + kq, nb = 2 * (r % 22) + nh; tr_item(a.in[6] + (size_t)l * DM * DIN, DM, DIN, wl + O_IN, kb, nb, 64 * nb, a.in[5] + l * DM, scr, lane, slice); continue; }
        r -= I_UP;
        if (r < I_OUT) { const int kb = 4 * (r / 8) + kq, nb = 2 * (r % 8) + nh; tr_item(a.in[9] + (size_t)l * DM * DM, DM, DM, wl + O_OUT, kb, nb, 64 * nb, nullptr, scr, lane, slice); continue; }
        r -= I_OUT;
        if (r < 2 * I_UP) { const int up = r >= I_UP; r -= up * I_UP; const int kb = 4 * (r / 22) + kq, nb = 2 * (r % 22) + nh, n0 = 64 * nb;
            tr_item(a.in[up ? 12 : 11] + (size_t)l * DM * FF, DM, FF, wl + O_GU2, kb, nb, 256 * (n0 >> 7) + (n0 & 127) + 128 * up, a.in[10] + l * DM, scr, lane, slice); continue; }
        r -= 2 * I_UP;
        { const int kb = 4 * (r / 8) + kq, nb = 2 * (r % 8) + nh; tr_item(a.in[13] + (size_t)l * FF * DM, FF, DM, wl + O_D2, kb, nb, 64 * nb, nullptr, scr, lane, slice); }
    }
    bf16* hb = (bf16*)(a.ws + WS_HB); float* part = (float*)(a.ws + WS_PART);
    for (int m = gw; m < M; m += NGW) {
        const f32x4* xr = (const f32x4*)(a.in[0] + (size_t)m * DM) + lane; u32x2* o8 = (u32x2*)(hb + (size_t)m * DM) + lane;
        float s = 0.f;
#pragma unroll
        for (int j = 0; j < 4; ++j) { const f32x4 v = xr[64 * j]; s += (v[0] * v[0] + v[1] * v[1]) + (v[2] * v[2] + v[3] * v[3]); u32x2 w; w.x = pk2(v[0], v[1]); w.y = pk2(v[2], v[3]); *(u32x2*)((unsigned char*)hb + pg8::a_tiled_off(m, 4 * (lane + 64 * j), DM)) = w; }
        s = wave_sum(s);
        if (lane < 16) part[(size_t)m * 16 + lane] = lane == 0 ? s : 0.f;
    }
    float* rc = (float*)(a.ws + WS_ROPE); float* rsn = rc + SEQ * 64;
    for (int i = blockIdx.x * 512 + tid; i < SEQ * 64; i += gridDim.x * 512) {
        const int pos = i >> 6, d = i & 63;
        const float inv = powf(10000.0f, -(float)(2 * d) / 128.0f);
        const float ang = (float)pos * inv;
        double t = (double)ang * 0.15915494309189535; t -= rint(t);
        const float rev = (float)t;
        rc[i] = __builtin_amdgcn_cosf(rev); rsn[i] = __builtin_amdgcn_sinf(rev);
    }
}

typedef short v4i16_t __attribute__((ext_vector_type(4)));
__device__ __forceinline__ s16x4 vtr(const LAS unsigned char* p) { return __builtin_bit_cast(s16x4, __builtin_amdgcn_ds_read_tr16_b64_v4i16((LAS v4i16_t*)p)); }
__device__ __forceinline__ bf16x8 tr_frag(const LAS unsigned char* p0, const LAS unsigned char* p1) { const s16x4 lo = vtr(p0), hi = vtr(p1); return __builtin_shufflevector(lo, hi, 0, 1, 2, 3, 4, 5, 6, 7); }

constexpr int ATT_KP = 144, ATT_VP = 160;
__device__ __forceinline__ void att_unit(LAS unsigned char* lds, const bf16* proj, bf16* mix, const float* sinks, int unit, int tid) {
    const int kvh = unit & 1, nblk = (unit >> 1) & 15, b = unit >> 5, t0 = b * SEQ + nblk * 128;
    LAS unsigned char* Kimg = lds; LAS unsigned char* Vimg = lds + 256 * ATT_KP;
    const int w = tid >> 6, lane = tid & 63, fr = lane & 15, fq = lane >> 4;
    const int head = kvh * 4 + (w >> 1), half = w & 1;
    u32x4 kk[4], vv[4];
#pragma unroll
    for (int i = 0; i < 4; ++i) {
        const int idx = tid + 512 * i, key = idx >> 3, ch = idx & 7;
        kk[i] = (u32x4){0u, 0u, 0u, 0u}; vv[i] = (u32x4){0u, 0u, 0u, 0u};
        if (nblk > 0 || key >= 128) { const bf16* rp = proj + (size_t)(t0 - 128 + key) * DIN + kvh * 64 + 8 * ch; kk[i] = *(const u32x4*)(rp + 512); vv[i] = *(const u32x4*)(rp + 640); }
    }
    const bf16* qbase = proj + (size_t)(t0 + 64 * half + fr) * DIN + head * 64 + 8 * fq;
    bf16x8 qn0 = *(const bf16x8*)qbase, qn1 = *(const bf16x8*)(qbase + 32);
    const float sink = sinks[head];
    __builtin_amdgcn_sched_barrier(0);
#pragma unroll
    for (int i = 0; i < 4; ++i) {
        const int idx = tid + 512 * i, key = idx >> 3, ch = idx & 7;
        *(LAS u32x4*)(Kimg + key * ATT_KP + 16 * ch) = kk[i]; *(LAS u32x4*)(Vimg + key * ATT_VP + 16 * ch) = vv[i];
    }
    __syncthreads();
    const int trofs = (fr >> 2) * ATT_VP + 8 * (fr & 3);
    for (int mt = 0; mt < 4; ++mt) {
        const int q0 = 64 * half + 16 * mt;
        const bf16x8 qf0 = qn0, qf1 = qn1;
        if (mt < 3) { const bf16* qp = qbase + (size_t)(16 * (mt + 1)) * DIN; qn0 = *(const bf16x8*)qp; qn1 = *(const bf16x8*)(qp + 32); }
        __builtin_amdgcn_sched_barrier(0);
        f32x4 s[9];
#pragma unroll
        for (int kt = 0; kt < 9; ++kt) {
            const LAS unsigned char* kp = Kimg + (q0 + 16 * kt + fr) * ATT_KP + 16 * fq;
            const bf16x8 k0 = *(const LAS bf16x8*)kp, k1 = *(const LAS bf16x8*)(kp + 64);
            f32x4 c = (f32x4){0.f, 0.f, 0.f, 0.f};
            c = MFMA16(k0, qf0, c); c = MFMA16(k1, qf1, c); s[kt] = c;
        }
        const int qi = q0 + fr;
        float mx = sink;
#pragma unroll
        for (int kt = 0; kt < 9; ++kt) {
            const bool tile_ok = (nblk > 0) || (q0 + 16 * kt >= 128);
#pragma unroll
            for (int r = 0; r < 4; ++r) {
                const bool ok = tile_ok && (kt == 0 ? (4 * fq + r > fr) : (kt == 8 ? (4 * fq + r <= fr) : true));
                const float v = ok ? s[kt][r] * 0.125f : -1e30f;
                s[kt][r] = v; mx = fmaxf(mx, v);
            }
        }
        mx = fmaxf(mx, __shfl_xor(mx, 16)); mx = fmaxf(mx, __shfl_xor(mx, 32));
        float sum = 0.f;
#pragma unroll
        for (int kt = 0; kt < 9; ++kt)
#pragma unroll
            for (int r = 0; r < 4; ++r) { const float p = __expf(s[kt][r] - mx); s[kt][r] = p; sum += p; }
        sum += __shfl_xor(sum, 16); sum += __shfl_xor(sum, 32);
        const float inv = 1.0f / (sum + __expf(sink - mx));
        f32x4 o[4];
#pragma unroll
        for (int dt = 0; dt < 4; ++dt) o[dt] = (f32x4){0.f, 0.f, 0.f, 0.f};
#pragma unroll
        for (int p = 0; p < 5; ++p) {
            u32x4 pw; pw.x = pk2(s[2 * p][0] * inv, s[2 * p][1] * inv); pw.y = pk2(s[2 * p][2] * inv, s[2 * p][3] * inv);
            if (p < 4) { pw.z = pk2(s[2 * p + 1][0] * inv, s[2 * p + 1][1] * inv); pw.w = pk2(s[2 * p + 1][2] * inv, s[2 * p + 1][3] * inv); } else { pw.z = 0u; pw.w = 0u; }
            const bf16x8 pb = __builtin_bit_cast(bf16x8, pw);
#pragma unroll
            for (int dt = 0; dt < 4; ++dt) {
                const LAS unsigned char* vp = Vimg + (q0 + 32 * p + 4 * fq) * ATT_VP + 32 * dt + trofs;
                const s16x4 lo = vtr(vp); s16x4 hi = (s16x4){0, 0, 0, 0}; if (p < 4) hi = vtr(vp + 16 * ATT_VP);
                o[dt] = MFMA16(__builtin_shufflevector(lo, hi, 0, 1, 2, 3, 4, 5, 6, 7), pb, o[dt]);
            }
        }
        bf16* op = mix + (size_t)(t0 + q0 + fr) * DM + head * 64 + 4 * fq;
#pragma unroll
        for (int dt = 0; dt < 4; ++dt) { u32x2 w2; w2.x = pk2(o[dt][0], o[dt][1]); w2.y = pk2(o[dt][2], o[dt][3]); *(u32x2*)((unsigned char*)mix + pg8::a_tiled_off(t0 + q0 + fr, head * 64 + 16 * dt + 4 * fq, DM)) = w2; }
    }
    __syncthreads();
}

__device__ __forceinline__ float ret_log_gamma(int h) { return logf(1.0f - exp2f(-5.0f - (float)h)); }
constexpr int RET_P = 288;
template <bool ZETA>
__device__ __forceinline__ void ret_load_kv(LAS unsigned char* Kimg, LAS unsigned char* Vimg, const bf16* proj, const float* rc, const float* rsn, int t0, int n, int h, float lg, int tid) {
    u32x4 klo[2], khi[2], vv[4]; f32x4 kc[2][2], ks_[2][2];
#pragma unroll
    for (int i = 0; i < 2; ++i) {
        const int idx = tid + 512 * i, j = idx >> 3, dc = idx & 7;
        const bf16* kp = proj + (size_t)(t0 + j) * DIN + 1280 + h * 128 + 8 * dc;
        klo[i] = *(const u32x4*)kp; khi[i] = *(const u32x4*)(kp + 64);
        const int pos = n * 128 + j;
        kc[i][0] = *(const f32x4*)(rc + pos * 64 + 8 * dc); kc[i][1] = *(const f32x4*)(rc + pos * 64 + 8 * dc + 4);
        ks_[i][0] = *(const f32x4*)(rsn + pos * 64 + 8 * dc); ks_[i][1] = *(const f32x4*)(rsn + pos * 64 + 8 * dc + 4);
    }
#pragma unroll
    for (int i = 0; i < 4; ++i) { const int idx = tid + 512 * i, j = idx >> 4, vc = idx & 15; vv[i] = *(const u32x4*)(proj + (size_t)(t0 + j) * DIN + 1792 + h * 128 + 8 * vc); }
    __builtin_amdgcn_sched_barrier(0);
#pragma unroll
    for (int i = 0; i < 2; ++i) {
        const int idx = tid + 512 * i, j = idx >> 3, dc = idx & 7;
        const float ksc = ZETA ? 0.08838834764831845f : 0.08838834764831845f * __expf(-(float)j * lg);
        float r1[8], r2[8];
#pragma unroll
        for (int e = 0; e < 8; ++e) {
            const float x1 = (e & 1) ? bfhi(klo[i][e >> 1]) : bflo(klo[i][e >> 1]), x2 = (e & 1) ? bfhi(khi[i][e >> 1]) : bflo(khi[i][e >> 1]);
            const float c = kc[i][e >> 2][e & 3], sn = ks_[i][e >> 2][e & 3];
            r1[e] = (x1 * c - x2 * sn) * ksc; r2[e] = (x1 * sn + x2 * c) * ksc;
        }
        u32x4 w1, w2; w1.x = pk2(r1[0], r1[1]); w1.y = pk2(r1[2], r1[3]); w1.z = pk2(r1[4], r1[5]); w1.w = pk2(r1[6], r1[7]);
        w2.x = pk2(r2[0], r2[1]); w2.y = pk2(r2[2], r2[3]); w2.z = pk2(r2[4], r2[5]); w2.w = pk2(r2[6], r2[7]);
        *(LAS u32x4*)(Kimg + j * RET_P + 16 * dc) = w1; *(LAS u32x4*)(Kimg + j * RET_P + 128 + 16 * dc) = w2;
    }
#pragma unroll
    for (int i = 0; i < 4; ++i) {
        const int idx = tid + 512 * i, j = idx >> 4, vc = idx & 15;
        u32x4 v = vv[i];
        if (ZETA) { const float z = __expf((float)(127 - j) * lg);
            v.x = pk2(bflo(v.x) * z, bfhi(v.x) * z); v.y = pk2(bflo(v.y) * z, bfhi(v.y) * z); v.z = pk2(bflo(v.z) * z, bfhi(v.z) * z); v.w = pk2(bflo(v.w) * z, bfhi(v.w) * z); }
        *(LAS u32x4*)(Vimg + j * RET_P + 16 * vc) = v;
    }
}
__device__ __forceinline__ void r1_unit(LAS unsigned char* lds, const bf16* proj, float* kv, const float* rc, const float* rsn, int unit, int tid) {
    const int h = unit & 3, n = (unit >> 2) & 15, b = unit >> 6, t0 = b * SEQ + n * 128;
    LAS unsigned char* Kimg = lds; LAS unsigned char* Vimg = lds + 128 * RET_P;
    const float lg = ret_log_gamma(h);
    ret_load_kv<true>(Kimg, Vimg, proj, rc, rsn, t0, n, h, lg, tid);
    __syncthreads();
    const int w = tid >> 6, lane = tid & 63, fr = lane & 15, fq = lane >> 4;
    const int trofs = (fr >> 2) * RET_P + 8 * (fr & 3);
    f32x4 acc[8];
#pragma unroll
    for (int dt = 0; dt < 8; ++dt) acc[dt] = (f32x4){0.f, 0.f, 0.f, 0.f};
#pragma unroll
    for (int ks = 0; ks < 4; ++ks) {
        const int rb = (32 * ks + 8 * fq) * RET_P + trofs;
        const bf16x8 af = tr_frag(Vimg + rb + 32 * w, Vimg + rb + 4 * RET_P + 32 * w);
#pragma unroll
        for (int dt = 0; dt < 8; ++dt) { const bf16x8 bfr = tr_frag(Kimg + rb + 32 * dt, Kimg + rb + 4 * RET_P + 32 * dt); acc[dt] = MFMA16(af, bfr, acc[dt]); }
    }
    float* o = kv + (size_t)unit * 16384;
#pragma unroll
    for (int dt = 0; dt < 8; ++dt)
#pragma unroll
        for (int r = 0; r < 4; ++r) o[(16 * w + 4 * fq + r) * 128 + 16 * dt + fr] = acc[dt][r];
    __syncthreads();
}
__device__ __forceinline__ void scan_phase(const float* kv, bf16* prev, int tid, int vb) {
    for (int i = vb * 512 + tid; i < 32 * 4096; i += gridDim.x * 512) {
        const int chain = i >> 12, e4 = i & 4095, b = chain >> 2, h = chain & 3;
        const float dec = __expf(128.0f * ret_log_gamma(h));
        f32x4 st = (f32x4){0.f, 0.f, 0.f, 0.f}, kq[15];
#pragma unroll
        for (int n = 0; n < 15; ++n) kq[n] = *(const f32x4*)(kv + (size_t)((b * 16 + n) * 4 + h) * 16384 + 4 * e4);
        __builtin_amdgcn_sched_barrier(0);
#pragma unroll
        for (int n = 0; n < 16; ++n) {
            const size_t off = (size_t)((b * 16 + n) * 4 + h) * 16384 + 4 * e4;
            u32x2 w; w.x = pk2(st[0], st[1]); w.y = pk2(st[2], st[3]); *(u32x2*)(prev + off) = w;
            if (n < 15) st = st * dec + kq[n];
        }
    }
}
__device__ __forceinline__ void r2_unit(LAS unsigned char* lds, const bf16* proj, const bf16* prev, bf16* mix, const float* rc, const float* rsn, const float* gnw, int unit, int tid) {
    const int h = unit & 3, n = (unit >> 2) & 15, b = unit >> 6, t0 = b * SEQ + n * 128;
    LAS unsigned char* Kimg = lds; LAS unsigned char* Vimg = lds + 128 * RET_P;
    const float lg = ret_log_gamma(h);
    const int w = tid >> 6, lane = tid & 63, fr = lane & 15, fq = lane >> 4;
    const int qi = 16 * w + fr, tok = t0 + qi, pos = n * 128 + qi;
    const int trofs = (fr >> 2) * RET_P + 8 * (fr & 3);
    u32x4 qlo[2], qhi[2]; f32x4 qc[2][2], qs[2][2];
    {
        const bf16* qp = proj + (size_t)tok * DIN + 768 + h * 128 + 8 * fq;
#pragma unroll
        for (int ks = 0; ks < 2; ++ks) {
            qlo[ks] = *(const u32x4*)(qp + 32 * ks); qhi[ks] = *(const u32x4*)(qp + 32 * ks + 64);
            const float* cp = rc + pos * 64 + 32 * ks + 8 * fq; const float* sp = rsn + pos * 64 + 32 * ks + 8 * fq;
            qc[ks][0] = *(const f32x4*)cp; qc[ks][1] = *(const f32x4*)(cp + 4); qs[ks][0] = *(const f32x4*)sp; qs[ks][1] = *(const f32x4*)(sp + 4);
        }
    }
    u32x4 pv[4];
    if (n > 0) {
        const bf16* pp = prev + (size_t)unit * 16384;
#pragma unroll
        for (int i = 0; i < 4; ++i) { const int idx = tid + 512 * i; pv[i] = *(const u32x4*)(pp + (idx >> 4) * 128 + 8 * (idx & 15)); }
    }
    __builtin_amdgcn_sched_barrier(0);
    ret_load_kv<false>(Kimg, Vimg, proj, rc, rsn, t0, n, h, lg, tid);
    LAS unsigned char* Pimg = lds + 2 * 128 * RET_P;
    if (n > 0) {
#pragma unroll
        for (int i = 0; i < 4; ++i) { const int idx = tid + 512 * i; *(LAS u32x4*)(Pimg + (idx >> 4) * 272 + 16 * (idx & 15)) = pv[i]; }
    }
    __syncthreads();
    bf16x8 q[4];
    const float gq = __expf((float)qi * lg);
#pragma unroll
    for (int ks = 0; ks < 2; ++ks) {
        float r1[8], r2[8];
#pragma unroll
        for (int e = 0; e < 8; ++e) {
            const float x1 = (e & 1) ? bfhi(qlo[ks][e >> 1]) : bflo(qlo[ks][e >> 1]), x2 = (e & 1) ? bfhi(qhi[ks][e >> 1]) : bflo(qhi[ks][e >> 1]);
            const float c = qc[ks][e >> 2][e & 3], sn = qs[ks][e >> 2][e & 3];
            r1[e] = (x1 * c - x2 * sn) * gq; r2[e] = (x1 * sn + x2 * c) * gq;
        }
        u32x4 w1, w2; w1.x = pk2(r1[0], r1[1]); w1.y = pk2(r1[2], r1[3]); w1.z = pk2(r1[4], r1[5]); w1.w = pk2(r1[6], r1[7]);
        w2.x = pk2(r2[0], r2[1]); w2.y = pk2(r2[2], r2[3]); w2.z = pk2(r2[4], r2[5]); w2.w = pk2(r2[6], r2[7]);
        q[ks] = __builtin_bit_cast(bf16x8, w1); q[ks + 2] = __builtin_bit_cast(bf16x8, w2);
    }
    f32x4 y[8];
#pragma unroll
    for (int vt = 0; vt < 8; ++vt) y[vt] = (f32x4){0.f, 0.f, 0.f, 0.f};
    if (n > 0) {
#pragma unroll
        for (int ks = 0; ks < 4; ++ks)
#pragma unroll
            for (int vt = 0; vt < 8; ++vt) { const bf16x8 af = *(const LAS bf16x8*)(Pimg + (16 * vt + fr) * 272 + 64 * ks + 16 * fq); y[vt] = MFMA16(af, q[ks], y[vt]); }
        const float gam = __expf(lg);
#pragma unroll
        for (int vt = 0; vt < 8; ++vt) y[vt] = y[vt] * gam;
    }
    f32x4 s[8];
#pragma unroll
    for (int jt = 0; jt < 8; ++jt) {
        s[jt] = (f32x4){0.f, 0.f, 0.f, 0.f};
        if (jt <= w) {
#pragma unroll
            for (int ks = 0; ks < 4; ++ks) { const bf16x8 af = *(const LAS bf16x8*)(Kimg + (16 * jt + fr) * RET_P + 64 * ks + 16 * fq); s[jt] = MFMA16(af, q[ks], s[jt]); }
            if (jt == w) {
#pragma unroll
                for (int r = 0; r < 4; ++r) { const int j = 16 * jt + 4 * fq + r; s[jt][r] = (qi >= j) ? s[jt][r] : 0.f; }
            }
        }
    }
#pragma unroll
    for (int p = 0; p < 4; ++p) {
        if (2 * p <= w) {
            u32x4 pw; pw.x = pk2(s[2 * p][0], s[2 * p][1]); pw.y = pk2(s[2 * p][2], s[2 * p][3]); pw.z = pk2(s[2 * p + 1][0], s[2 * p + 1][1]); pw.w = pk2(s[2 * p + 1][2], s[2 * p + 1][3]);
            const bf16x8 pb = __builtin_bit_cast(bf16x8, pw);
#pragma unroll
            for (int vt = 0; vt < 8; ++vt) {
                const LAS unsigned char* vp = Vimg + (32 * p + 4 * fq) * RET_P + 32 * vt + trofs;
                y[vt] = MFMA16(tr_frag(vp, vp + 16 * RET_P), pb, y[vt]);
            }
        }
    }
    float sm = 0.f;
#pragma unroll
    for (int vt = 0; vt < 8; ++vt) sm += (y[vt][0] + y[vt][1]) + (y[vt][2] + y[vt][3]);
    sm += __shfl_xor(sm, 16); sm += __shfl_xor(sm, 32);
    const float mu = sm * (1.0f / 128.0f);
    float sq = 0.f;
#pragma unroll
    for (int vt = 0; vt < 8; ++vt) { y[vt] = y[vt] - mu; sq += (y[vt][0] * y[vt][0] + y[vt][1] * y[vt][1]) + (y[vt][2] * y[vt][2] + y[vt][3] * y[vt][3]); }
    sq += __shfl_xor(sq, 16); sq += __shfl_xor(sq, 32);
    const float rstd = 1.0f / sqrtf(sq * (1.0f / 128.0f) + 1e-5f);
    const bf16* gp = proj + (size_t)tok * DIN + 2304 + h * 128 + 4 * fq;
    bf16* op = mix + (size_t)tok * DM + 512 + h * 128 + 4 * fq;
    const float* gw = gnw + h * 128 + 4 * fq;
    u32x2 gva[8]; f32x4 wva[8];
#pragma unroll
    for (int vt = 0; vt < 8; ++vt) { gva[vt] = *(const u32x2*)(gp + 16 * vt); wva[vt] = *(const f32x4*)(gw + 16 * vt); }
    __builtin_amdgcn_sched_barrier(0);
#pragma unroll
    for (int vt = 0; vt < 8; ++vt) {
        const u32x2 gv = gva[vt]; const f32x4 wv = wva[vt];
        const float g0 = bflo(gv.x), g1 = bfhi(gv.x), g2 = bflo(gv.y), g3 = bfhi(gv.y);
        const float o0 = g0 * (y[vt][0] * rstd * wv[0]), o1 = g1 * (y[vt][1] * rstd * wv[1]);
        const float o2 = g2 * (y[vt][2] * rstd * wv[2]), o3 = g3 * (y[vt][3] * rstd * wv[3]);
        u32x2 w2; w2.x = pk2(o0, o1); w2.y = pk2(o2, o3); *(u32x2*)((unsigned char*)mix + pg8::a_tiled_off(tok, 512 + h * 128 + 16 * vt + 4 * fq, DM)) = w2;
    }
    __syncthreads();
}

__device__ __forceinline__ void final_phase(float* out, const bf16* hb, const float* part, const float* wf, int tid, int vb) {
    const int lane = tid & 63, G = gridDim.x;
    const int m_lo = (G == 256) ? vb * 64 + (tid >> 6) : vb * NWAVES + (tid >> 6), m_hi = (G == 256) ? vb * 64 + 64 : M, m_st = (G == 256) ? NWAVES : G * NWAVES;
    for (int m = m_lo; m < m_hi; m += m_st) {
        float s = lane < 16 ? part[(size_t)m * 16 + lane] : 0.f;
        s = wave_sum(s);
        const float rs = 1.0f / sqrtf(s * (1.0f / 1024.0f) + 1e-6f);
        const u32x2* hr = (const u32x2*)(hb + (size_t)m * DM) + lane; f32x4* xr = (f32x4*)(out + (size_t)m * DM) + lane; const f32x4* wr = (const f32x4*)wf + lane;
#pragma unroll
        for (int j = 0; j < 4; ++j) { const u32x2 hv = *(const u32x2*)((const unsigned char*)hb + pg8::a_tiled_off(m, 4 * (lane + 64 * j), DM)); const f32x4 v = (f32x4){bflo(hv.x), bfhi(hv.x), bflo(hv.y), bfhi(hv.y)}; xr[64 * j] = v * rs * wr[64 * j]; }
    }
}

constexpr int RTAB_OFF = 131072;
__device__ __forceinline__ void rstd_table(LAS unsigned char* lds, const float* part, int pm0, int pm1, int tid) {
    const int r = tid >> 1, hs = tid & 1;
    if (pm0 >= 0) {
        const int pmb = pm1 >= 0 ? pm1 : pm0;
        const float* p0 = part + (size_t)(pm0 * 256 + r) * 16 + 8 * hs; const float* p1 = part + (size_t)(pmb * 256 + r) * 16 + 8 * hs;
        const f32x4 a0 = *(const f32x4*)p0, b0 = *(const f32x4*)(p0 + 4), a1 = *(const f32x4*)p1, b1 = *(const f32x4*)(p1 + 4);
        float s0 = ((a0[0] + a0[1]) + (a0[2] + a0[3])) + ((b0[0] + b0[1]) + (b0[2] + b0[3]));
        float s1 = ((a1[0] + a1[1]) + (a1[2] + a1[3])) + ((b1[0] + b1[1]) + (b1[2] + b1[3]));
        s0 += __shfl_xor(s0, 1); s1 += __shfl_xor(s1, 1);
        if (hs == 0) { LAS float* rt = (LAS float*)(lds + RTAB_OFF); rt[r] = 1.0f / sqrtf(s0 * (1.0f / 1024.0f) + 1e-6f); rt[256 + r] = 1.0f / sqrtf(s1 * (1.0f / 1024.0f) + 1e-6f); }
    }
    __syncthreads();
}

__global__ void __launch_bounds__(NWAVES * 64, 2) fwd_kernel(Args a) {
    extern __shared__ __attribute__((aligned(16))) unsigned char lds_raw[];
    LAS unsigned char* lds = (LAS unsigned char*)lds_raw;
    const int G = gridDim.x;
#define BAR_CTL ((unsigned*)(a.ws + WS_CTL))
#define BAR_ST ((volatile LAS unsigned*)(lds + LDS_BARST))
#define BAR_X (a.use_sync ? xb_xcc_id() : 0u)
    if (a.use_sync) {
        if (threadIdx.x < 16) ((LAS unsigned*)(lds + LDS_BARST))[threadIdx.x] = 0u;
        __syncthreads();
        if (threadIdx.x == 0) BAR_ST[2] = xb_add(&BAR_CTL[XB_XCNT(xb_xcc_id())], 1u);
    }
#pragma nounroll
    for (int ph = a.ph_lo; ph < a.ph_hi; ++ph) {
        const int sidx = (ph == 0) ? 9 : ((ph == NPH - 1) ? 10 : (ph - 1) % 9);
        const int nrep = ((PROBE_REP_MASK >> sidx) & 1) ? 2 : 1;
#pragma nounroll
        for (int rep = 0; rep < nrep; ++rep) {
        int tid = threadIdx.x; asm volatile("" : "+v"(tid));
        const unsigned xmode = a.use_sync ? BAR_ST[3] : 0u, xrank = a.use_sync ? BAR_ST[2] : 0u;
        const int vcu = xmode ? (int)(xrank * 8u + BAR_X) : (int)blockIdx.x;
        const int vb = xmode ? (int)(BAR_X * 32u + xrank) : (int)blockIdx.x;
        size_t wsz = 0; asm volatile("" : "+s"(wsz)); unsigned char* ws = a.ws + wsz;
        bf16* hb = (bf16*)(ws + WS_HB); bf16* act = (bf16*)(ws + WS_ACT); bf16* mix = (bf16*)(ws + WS_MIX);
        float* part = (float*)(ws + WS_PART); float* kv = (float*)(ws + WS_KV); bf16* prev = (bf16*)(ws + WS_PREV);
        const float* rc = (const float*)(ws + WS_ROPE); const float* rsn = rc + SEQ * 64;
        if (ph == 0) prologue(a, lds, tid);
        else if (ph == NPH - 1) final_phase(a.out, hb, part, a.in[14], tid, vb);
        else {
            const int l = (ph - 1) / 9, s = (ph - 1) % 9;
            const bf16* wl = (const bf16*)(ws + WS_W) + (size_t)l * L_STRIDE;
            if (s == 0 || s == 7) {
                pg8::Gemm g{hb, wl + (s == 0 ? O_GU1 : O_GU2), M, 2 * FF, DM}; pg8::StaticOrder S; S.init(M, 2 * FF, G, vcu);
                pg8::Unit u0, uh; u0.pm = -1; uh.pm = -1; (void)S.next(0, u0); (void)S.next(S.nwg / S.G, uh);
                rstd_table(lds, part, u0.pm, uh.pm, tid);
                pg8::EpiSwiGLU E{act, FF, part, (const LAS float*)(lds + RTAB_OFF), u0.pm, uh.pm};
                pg8::gemm_phase<pg8::EpiSwiGLU, pg8::StaticOrder, true, true>(lds, g, S, E);
            } else if (s == 1 || s == 8 || s == 6) {
                const bool isout = (s == 6);
                pg8::Gemm g{isout ? mix : act, wl + (s == 1 ? O_D1 : (s == 8 ? O_D2 : O_OUT)), M, DM, isout ? DM : FF}; pg8::StaticOrder S; S.init(M, DM, G, vcu);
                pg8::EpiResid E{hb, part, (rep + 1 < nrep) ? 0.0f : (isout ? 1.0f : 0.5f)};
                pg8::gemm_phase<pg8::EpiResid, pg8::StaticOrder, true, true>(lds, g, S, E);
            } else if (s == 2) {
                pg8::Gemm g{hb, wl + O_IN, M, DIN, DM}; pg8::StaticOrder S; S.init(M, DIN, G, vcu);
                pg8::Unit u0; u0.pm = -1; (void)S.next(0, u0);
                rstd_table(lds, part, u0.pm, -1, tid);
                pg8::EpiScaleBf16 E{act, DIN, part, 9, (const LAS float*)(lds + RTAB_OFF), u0.pm};
                pg8::gemm_phase<pg8::EpiScaleBf16, pg8::StaticOrder, true, true>(lds, g, S, E);
            } else if (s == 3) {
                for (int u = vb; u < 256; u += G) att_unit(lds, act, mix, a.in[7] + l * 8, u, tid);
                if (G == 256) { for (int k = 0; k < 2; ++k) r1_unit(lds, act, kv, rc, rsn, (vb >> 5) * 64 + (vb & 31) + 32 * k, tid); }
                else for (int u = vb; u < 512; u += G) r1_unit(lds, act, kv, rc, rsn, u, tid);
            } else if (s == 4) {
                scan_phase(kv, prev, tid, vb);
            } else {
                if (G == 256) { for (int k = 0; k < 2; ++k) r2_unit(lds, act, prev, mix, rc, rsn, a.in[8] + l * 512, (vb >> 5) * 64 + (vb & 31) + 32 * k, tid); }
                else for (int u = vb; u < 512; u += G) r2_unit(lds, act, prev, mix, rc, rsn, a.in[8] + l * 512, u, tid);
            }
        }
        }
        if (ph + 1 < a.ph_hi && a.use_sync) {
            if (ph == 0) {
                if (G != 256) cg::this_grid().sync();
                else { XcdBarrier bar; bar.bar = BAR_CTL; bar.x = xb_xcc_id(); bar.st = BAR_ST; xcd_barrier(bar); }
                if (threadIdx.x == 0) {
                    unsigned nloc = 0u, nx = 0u, ok = (G == 256) ? 1u : 0u;
                    const unsigned myx = xb_xcc_id();
                    for (unsigned j = 0; j < 16; ++j) { const unsigned c = xb_ld(&BAR_CTL[XB_XCNT(j)]); nx += c ? 1u : 0u; if (j == myx) nloc = c; if (c != (j < 8u ? 32u : 0u)) ok = 0u; }
                    BAR_ST[0] = nloc ? nloc : 1u; BAR_ST[1] = nx ? nx : 1u; BAR_ST[3] = ok;
                }
                __syncthreads();
            } else if (BAR_ST[3]) xcd_local_barrier(BAR_CTL, xb_xcc_id(), BAR_ST[0]);
            else { XcdBarrier bar; bar.bar = BAR_CTL; bar.x = xb_xcc_id(); bar.st = BAR_ST; xcd_barrier(bar); }
        }
    }
}

extern "C" void kernel_launch(void* const* d_in, const int* in_sizes, int n_in, void* d_out, int out_size, void* d_ws, size_t ws_size, hipStream_t stream) {
    static int grid = 0;
    if (grid == 0) {
        if (n_in != 15 || out_size != M * DM || ws_size < WS_END) { fprintf(stderr, "kernel_launch: unexpected shapes (n_in %d out %d ws %zu)\n", n_in, out_size, ws_size); grid = -1; return; }
        if (hipFuncSetAttribute((const void*)fwd_kernel, hipFuncAttributeMaxDynamicSharedMemorySize, LDS_BYTES) != hipSuccess) { fprintf(stderr, "kernel_launch: hipFuncSetAttribute failed\n"); grid = -1; return; }
        int dev = 0, cus = 0, per_cu = 0;
        hipGetDevice(&dev); hipDeviceGetAttribute(&cus, hipDeviceAttributeMultiprocessorCount, dev);
        hipOccupancyMaxActiveBlocksPerMultiprocessor(&per_cu, (const void*)fwd_kernel, NWAVES * 64, LDS_BYTES);
        (void)hipGetLastError();
        if (per_cu < 1) per_cu = 1;
        grid = cus > 0 ? cus : 256;
    }
    if (grid < 0) return;
    if (hipMemsetAsync((char*)d_ws + WS_CTL, 0, CTL_ZERO_BYTES, stream) != hipSuccess) { fprintf(stderr, "kernel_launch: memset failed\n"); return; }
    Args a{};
    for (int i = 0; i < 15; ++i) a.in[i] = (const float*)d_in[i];
    a.out = (float*)d_out; a.ws = (unsigned char*)d_ws;
#if MK_MULTI
    for (int ph = 0; ph < NPH; ++ph) { a.ph_lo = ph; a.ph_hi = ph + 1; a.use_sync = 0; hipLaunchKernelGGL(fwd_kernel, dim3(grid), dim3(NWAVES * 64), LDS_BYTES, stream, a); }
#else
    a.ph_lo = 0; a.ph_hi = NPH; a.use_sync = 1;
    void* args[] = {&a};
    hipError_t e = hipLaunchCooperativeKernel((const void*)fwd_kernel, dim3(grid), dim3(NWAVES * 64), args, LDS_BYTES, stream);
    if (e != hipSuccess) fprintf(stderr, "cooperative launch failed: %s (grid %d)\n", hipGetErrorString(e), grid);
#endif
}
```
